# Optimizing an MI355X kernel written in HIP

```python
import jax, jax.numpy as jnp
from jax import lax
import numpy as np

D_MODEL = 1024
BATCH = 8
SEQ = 8192
DEPTH = 2

GRID_W = 64
N_MEM = 256
HEAD_DIM = 64
NA_HEADS = 8
NA_WIDTH = NA_HEADS * HEAD_DIM
NA_KH = 8
NA_KW = 16
RW_HEADS = 4
RW_WIDTH = RW_HEADS * HEAD_DIM
RW_LORA_W = 64
RW_LORA_A = 64
RW_LORA_G = 128
RW_PROJ = 3 * RW_WIDTH + 2 * RW_LORA_W + 2 * RW_LORA_A + RW_LORA_G
MEM_HEADS = 4
MEM_WIDTH = MEM_HEADS * HEAD_DIM
D_MIX = NA_WIDTH + RW_WIDTH + MEM_WIDTH
P_IN = 3 * NA_WIDTH + RW_PROJ + MEM_WIDTH
MOE_GROUPS = 4
MOE_EXPERTS_PER_GROUP = 4
MOE_EXPERTS = MOE_GROUPS * MOE_EXPERTS_PER_GROUP
MOE_TOP_K = 2
MOE_D_FF = 512
MOE_BLOCK = 128
RMS_EPS = 1e-6
RW_GN_EPS = 64e-5

kernel_name = 'hybrid_natten_rwkv7_hmoe_encoder'


def rms_norm(x, w):
    xf = x.astype(jnp.float32)
    y = xf * lax.rsqrt(jnp.mean(xf * xf, axis=-1, keepdims=True) + RMS_EPS)
    return (y * w.astype(jnp.float32)).astype(x.dtype)


def neighborhood_attention(q, k, v, rpb):
    B, S, H, dh = q.shape
    rows = S // GRID_W
    kh = min(NA_KH, rows)
    col = np.arange(GRID_W)
    col_start = np.clip(col - NA_KW // 2, 0, GRID_W - NA_KW)
    col_idx = col_start[:, None] + np.arange(NA_KW)[None, :]
    dc = col_idx - col[:, None]
    qg = q.reshape(B, rows, GRID_W, H, dh)
    kg = k.reshape(B, rows, GRID_W, H, dh)
    vg = v.reshape(B, rows, GRID_W, H, dh)
    scale = HEAD_DIM ** -0.5

    def one_row(r):
        rs = jnp.clip(r - kh // 2, 0, rows - kh)
        k_rows = lax.dynamic_slice_in_dim(kg, rs, kh, axis=1)
        v_rows = lax.dynamic_slice_in_dim(vg, rs, kh, axis=1)
        k_nb = k_rows[:, :, col_idx]
        v_nb = v_rows[:, :, col_idx]
        q_r = lax.dynamic_index_in_dim(qg, r, axis=1, keepdims=False)
        dr = rs + jnp.arange(kh) - r
        bias = rpb[:, dr[:, None, None] + NA_KH - 1, dc[None, :, :] + NA_KW - 1]
        s = jnp.einsum('bqhd,bnqmhd->bhqnm', q_r, k_nb).astype(jnp.float32) * scale
        s = s + jnp.transpose(bias, (0, 2, 1, 3)).astype(jnp.float32)[None]
        p = jax.nn.softmax(s.reshape(B, H, GRID_W, kh * NA_KW), axis=-1)
        p = p.reshape(B, H, GRID_W, kh, NA_KW).astype(v.dtype)
        return jnp.einsum('bhqnm,bnqmhd->bqhd', p, v_nb)

    out = lax.map(one_row, jnp.arange(rows))
    return jnp.transpose(out, (1, 0, 2, 3, 4)).reshape(B, S, H * dh)


def centred_shift(s, mu_prev, mu_next):
    prev = jnp.pad(s, ((0, 0), (1, 0), (0, 0)))[:, :-1]
    nxt = jnp.pad(s, ((0, 0), (0, 1), (0, 0)))[:, 1:]
    return s + mu_prev * (prev - s) + mu_next * (nxt - s)


def wkv7_scan(r, w, k, v, kk, a, reverse):
    B, S, H, N = r.shape

    def step(state, inp):
        r_t, w_t, k_t, v_t, kk_t, a_t = inp
        sa = jnp.einsum('bhvk,bhk->bhv', state, -kk_t)
        state = (state * w_t[:, :, None, :]
                 + sa[..., None] * (kk_t * a_t)[:, :, None, :]
                 + v_t[..., None] * k_t[:, :, None, :])
        return state, jnp.einsum('bhvk,bhk->bhv', state, r_t)

    xs = tuple(jnp.swapaxes(t, 0, 1) for t in (r, w, k, v, kk, a))
    state0 = jnp.zeros((B, H, N, N), jnp.float32)
    _, y = lax.scan(step, state0, xs, reverse=reverse)
    return jnp.swapaxes(y, 0, 1)


def rwkv7_bidirectional(rw, mu_prev, mu_next, w0, w2, a0, a2, g2, k_k, k_a, r_k, ln_w, ln_b):
    f32 = jnp.float32
    B, S, _ = rw.shape
    rw = centred_shift(rw.astype(f32), mu_prev.astype(f32), mu_next.astype(f32))
    splits = [RW_WIDTH, 2 * RW_WIDTH, 3 * RW_WIDTH,
              3 * RW_WIDTH + RW_LORA_W, 3 * RW_WIDTH + 2 * RW_LORA_W,
              3 * RW_WIDTH + 2 * RW_LORA_W + RW_LORA_A,
              3 * RW_WIDTH + 2 * RW_LORA_W + 2 * RW_LORA_A]
    r, k, v, lw_f, lw_b, la_f, la_b, lg = jnp.split(rw, splits, axis=-1)
    w0, w2, a0, a2, g2 = (t.astype(f32) for t in (w0, w2, a0, a2, g2))

    def heads(t):
        return t.reshape(B, S, RW_HEADS, HEAD_DIM)

    g = jax.nn.sigmoid(lg) @ g2
    kk = heads(k * k_k.astype(f32))
    kk = kk / jnp.maximum(jnp.sqrt(jnp.sum(kk * kk, axis=-1, keepdims=True)), 1e-12)
    rh, vh = heads(r), heads(v)
    ys = []
    kds = []
    for d, (lw, la, rev) in enumerate(((lw_f, la_f, False), (lw_b, la_b, True))):
        wl = -jax.nn.softplus(-(w0[d] + jnp.tanh(lw) @ w2[d])) - 0.5
        decay = jnp.exp(-jnp.exp(wl))
        a = jax.nn.sigmoid(a0[d] + la @ a2[d])
        kd = k * (1.0 + (a - 1.0) * k_a.astype(f32))
        ys.append(wkv7_scan(rh, heads(decay), heads(kd), vh, kk, heads(a), rev))
        kds.append(kd)
    y = ys[0] + ys[1]
    mu = jnp.mean(y, axis=-1, keepdims=True)
    var = jnp.mean((y - mu) ** 2, axis=-1, keepdims=True)
    yn = ((y - mu) * lax.rsqrt(var + RW_GN_EPS)).reshape(B, S, RW_WIDTH)
    yn = yn * ln_w.astype(f32) + ln_b.astype(f32)
    bonus = jnp.sum(rh * heads(kds[0] + kds[1]) * r_k.astype(f32), axis=-1, keepdims=True) * vh
    return (yn + bonus.reshape(B, S, RW_WIDTH)) * g


def memory_cross_attention(mq, mem_n, w_mem_kv, q_norm_w, k_norm_w):
    B, S, _ = mq.shape
    M = mem_n.shape[1]
    q = rms_norm(mq.reshape(B, S, MEM_HEADS, HEAD_DIM), q_norm_w)
    k, v = jnp.split(mem_n @ w_mem_kv, 2, axis=-1)
    k = rms_norm(k.reshape(B, M, MEM_HEADS, HEAD_DIM), k_norm_w)
    v = v.reshape(B, M, MEM_HEADS, HEAD_DIM)
    s = jnp.einsum('bshd,bmhd->bhsm', q, k).astype(jnp.float32) * (HEAD_DIM ** -0.5)
    p = jax.nn.softmax(s, axis=-1).astype(v.dtype)
    return jnp.einsum('bhsm,bmhd->bshd', p, v).reshape(B, S, MEM_WIDTH)


def hybrid_mixer(h, mem_n, w_in, na_q_norm_w, na_k_norm_w, na_rpb,
                 rw_mu_prev, rw_mu_next, rw_w0, rw_w2, rw_a0, rw_a2, rw_g2,
                 rw_k_k, rw_k_a, rw_r_k, rw_ln_w, rw_ln_b,
                 w_mem_kv, mem_q_norm_w, mem_k_norm_w, w_out):
    B, S, _ = h.shape
    proj = h @ w_in
    na_qkv, rw, mq = jnp.split(proj, [3 * NA_WIDTH, 3 * NA_WIDTH + RW_PROJ], axis=-1)
    q, k, v = [t.reshape(B, S, NA_HEADS, HEAD_DIM) for t in jnp.split(na_qkv, 3, axis=-1)]
    q = rms_norm(q, na_q_norm_w)
    k = rms_norm(k, na_k_norm_w)
    y_na = neighborhood_attention(q, k, v, na_rpb)
    y_rw = rwkv7_bidirectional(rw, rw_mu_prev, rw_mu_next, rw_w0, rw_w2, rw_a0, rw_a2, rw_g2,
                               rw_k_k, rw_k_a, rw_r_k, rw_ln_w, rw_ln_b).astype(h.dtype)
    y_mem = memory_cross_attention(mq, mem_n, w_mem_kv, mem_q_norm_w, mem_k_norm_w)
    return jnp.concatenate([y_na, y_rw, y_mem], axis=-1) @ w_out


def hierarchical_moe(h, w_group, b_group, w_expert, b_expert, w_gate, w_up, w_down):
    B, S, D = h.shape
    n = B * S
    h2 = h.reshape(n, D)
    f32 = jnp.float32
    glogits = (h2 @ w_group).astype(f32) + b_group.astype(f32)
    g_idx = jnp.argmax(glogits, axis=-1)
    g_w = jnp.take_along_axis(jax.nn.softmax(glogits, axis=-1), g_idx[:, None], axis=1)[:, 0]
    elogits = ((h2 @ w_expert).astype(f32) + b_expert.astype(f32)).reshape(n, MOE_GROUPS, MOE_EXPERTS_PER_GROUP)
    sel = jnp.take_along_axis(elogits, g_idx[:, None, None], axis=1)[:, 0]
    top_p, top_i = lax.top_k(jax.nn.softmax(sel, axis=-1), MOE_TOP_K)
    top_p = top_p / jnp.sum(top_p, axis=-1, keepdims=True)
    weights = g_w[:, None] * top_p
    expert = g_idx[:, None] * MOE_EXPERTS_PER_GROUP + top_i
    nk = n * MOE_TOP_K
    flat_e = expert.reshape(-1).astype(jnp.int32)
    flat_w = weights.reshape(-1)
    flat_t = jnp.repeat(jnp.arange(n, dtype=jnp.int32), MOE_TOP_K)
    order = jnp.argsort(flat_e)
    se, st, sw = flat_e[order], flat_t[order], flat_w[order]
    counts = jnp.bincount(flat_e, length=MOE_EXPERTS).astype(jnp.int32)
    starts = jnp.cumsum(counts) - counts
    padded = (counts + MOE_BLOCK - 1) // MOE_BLOCK * MOE_BLOCK
    pends = jnp.cumsum(padded)
    pstarts = pends - padded
    dest = pstarts[se] + jnp.arange(nk, dtype=jnp.int32) - starts[se]
    n_blocks = -(-nk // MOE_BLOCK) + MOE_EXPERTS
    cap = n_blocks * MOE_BLOCK
    tok_buf = jnp.zeros((cap,), jnp.int32).at[dest].set(st)
    w_buf = jnp.zeros((cap,), h2.dtype).at[dest].set(sw.astype(h2.dtype))
    block_start = jnp.arange(n_blocks, dtype=jnp.int32) * MOE_BLOCK
    block_e = jnp.clip(jnp.searchsorted(pends, block_start, side='right'), 0, MOE_EXPERTS - 1)

    def run_block(args):
        e, toks, wts = args
        xb = h2[toks]
        hid = jax.nn.silu(xb @ w_gate[e]) * (xb @ w_up[e])
        return (hid @ w_down[e]) * wts[:, None]

    out = lax.map(run_block, (block_e, tok_buf.reshape(n_blocks, MOE_BLOCK),
                              w_buf.reshape(n_blocks, MOE_BLOCK)))
    y = jnp.zeros((n, D), h2.dtype).at[tok_buf].add(out.reshape(cap, D))
    return y.reshape(B, S, D)


def setup_inputs(seed: int = 0) -> dict:
    key = jax.random.key(seed)
    ks = iter(jax.random.split(key, 48))
    L = DEPTH

    def nrm(shape, scale):
        return jax.random.normal(next(ks), shape, jnp.float32) * scale

    def gain(shape):
        return 1.0 + nrm(shape, 0.02)

    def unif(shape, lo, hi):
        return jax.random.uniform(next(ks), shape, jnp.float32, lo, hi)

    return {
        'x': nrm((BATCH, SEQ, D_MODEL), 1.0),
        'mem': nrm((BATCH, N_MEM, D_MODEL), 1.0),
        'attn_norm_w': gain((L, D_MODEL)),
        'w_in': nrm((L, D_MODEL, P_IN), D_MODEL ** -0.5),
        'na_q_norm_w': gain((L, HEAD_DIM)),
        'na_k_norm_w': gain((L, HEAD_DIM)),
        'na_rpb': nrm((L, NA_HEADS, 2 * NA_KH - 1, 2 * NA_KW - 1), 0.02),
        'rw_mu_prev': unif((L, RW_PROJ), 0.1, 0.5),
        'rw_mu_next': unif((L, RW_PROJ), 0.1, 0.5),
        'rw_w0': unif((L, 2, RW_WIDTH), -5.0, 0.5),
        'rw_w2': nrm((L, 2, RW_LORA_W, RW_WIDTH), 0.1 * RW_LORA_W ** -0.5),
        'rw_a0': nrm((L, 2, RW_WIDTH), 0.1),
        'rw_a2': nrm((L, 2, RW_LORA_A, RW_WIDTH), 0.5 * RW_LORA_A ** -0.5),
        'rw_g2': nrm((L, RW_LORA_G, RW_WIDTH), RW_LORA_G ** -0.5),
        'rw_k_k': 0.85 + nrm((L, RW_WIDTH), 0.02),
        'rw_k_a': 1.0 + nrm((L, RW_WIDTH), 0.02),
        'rw_r_k': nrm((L, RW_HEADS, HEAD_DIM), 0.1),
        'rw_ln_w': gain((L, RW_WIDTH)),
        'rw_ln_b': nrm((L, RW_WIDTH), 0.02),
        'mem_norm_w': gain((L, D_MODEL)),
        'w_mem_kv': nrm((L, D_MODEL, 2 * MEM_WIDTH), D_MODEL ** -0.5),
        'mem_q_norm_w': gain((L, HEAD_DIM)),
        'mem_k_norm_w': gain((L, HEAD_DIM)),
        'w_out': nrm((L, D_MIX, D_MODEL), D_MIX ** -0.5),
        'ffn_norm_w': gain((L, D_MODEL)),
        'moe_w_group': nrm((L, D_MODEL, MOE_GROUPS), D_MODEL ** -0.5),
        'moe_b_group': nrm((L, MOE_GROUPS), 0.01),
        'moe_w_expert': nrm((L, D_MODEL, MOE_EXPERTS), D_MODEL ** -0.5),
        'moe_b_expert': nrm((L, MOE_EXPERTS), 0.01),
        'moe_w_gate': nrm((L, MOE_EXPERTS, D_MODEL, MOE_D_FF), D_MODEL ** -0.5),
        'moe_w_up': nrm((L, MOE_EXPERTS, D_MODEL, MOE_D_FF), D_MODEL ** -0.5),
        'moe_w_down': nrm((L, MOE_EXPERTS, MOE_D_FF, D_MODEL), MOE_D_FF ** -0.5),
    }


def reference(x, mem, attn_norm_w, w_in, na_q_norm_w, na_k_norm_w, na_rpb,
              rw_mu_prev, rw_mu_next, rw_w0, rw_w2, rw_a0, rw_a2, rw_g2,
              rw_k_k, rw_k_a, rw_r_k, rw_ln_w, rw_ln_b,
              mem_norm_w, w_mem_kv, mem_q_norm_w, mem_k_norm_w, w_out,
              ffn_norm_w, moe_w_group, moe_b_group, moe_w_expert, moe_b_expert,
              moe_w_gate, moe_w_up, moe_w_down):
    for l in range(DEPTH):
        h = rms_norm(x, attn_norm_w[l])
        mem_n = rms_norm(mem, mem_norm_w[l])
        x = x + hybrid_mixer(h, mem_n, w_in[l], na_q_norm_w[l], na_k_norm_w[l], na_rpb[l],
                             rw_mu_prev[l], rw_mu_next[l], rw_w0[l], rw_w2[l], rw_a0[l], rw_a2[l],
                             rw_g2[l], rw_k_k[l], rw_k_a[l], rw_r_k[l], rw_ln_w[l], rw_ln_b[l],
                             w_mem_kv[l], mem_q_norm_w[l], mem_k_norm_w[l], w_out[l])
        x = x + hierarchical_moe(rms_norm(x, ffn_norm_w[l]), moe_w_group[l], moe_b_group[l],
                                 moe_w_expert[l], moe_b_expert[l], moe_w_gate[l],
                                 moe_w_up[l], moe_w_down[l])
    return x
```

```cpp
#include <hip/hip_runtime.h>
#include <cstdio>
#include <cstdint>

#define LAS __attribute__((address_space(3)))
typedef unsigned short bf16_t;
typedef short bf16x8 __attribute__((ext_vector_type(8)));
typedef float f32x4 __attribute__((ext_vector_type(4)));
typedef unsigned u32x2 __attribute__((ext_vector_type(2)));
typedef unsigned u32x4 __attribute__((ext_vector_type(4)));

#ifndef EXTRA_BARS
#define EXTRA_BARS 0
#ifndef SCAN_VAR
#define SCAN_VAR 0
#endif
#endif
#ifndef DYN_GEMM
#define DYN_GEMM 0
#endif
#ifndef EPI_REP
#define EPI_REP 1
#endif
#ifndef KLOOP_REP
#define KLOOP_REP 1
#endif
#ifndef DUP_PH
#define DUP_PH -1
#endif
#ifndef NAIVE_SCAN
#define NAIVE_SCAN 0
#endif
#ifndef BRUTE_ATTN
#define BRUTE_ATTN 0
#endif
#ifndef SELFTEST
#define SELFTEST 0
#endif
#ifndef ST_FIRST
#define ST_FIRST 18
#endif
#ifndef ST_LAST
#define ST_LAST 21
#endif
#ifndef ABL
#define ABL 0
#endif
#ifndef MK_ONE_LAUNCH
#define MK_ONE_LAUNCH 1
#endif

constexpr int NB = 8, SEQ = 8192, DM = 1024, NT = NB * SEQ, NMEM = 256, NMROWS = NB * NMEM;
constexpr int PIN = 2944, PINP = 3072;
constexpr int PA_LD = 1792, PR_LD = 1152;
constexpr int C_K = 512, C_V = 1024, C_MQ = 1536;
constexpr int SRC_RW = 1536, SRC_MQ = 2688;
constexpr int MPAD = NT + 24 * 256;
constexpr int NWAVES = 8, NTHREADS = 512, GRID = 256;
constexpr int LDS_BYTES = 148 * 1024;
constexpr int LDS_RPB = 146 * 1024;
constexpr int LDS_MISC = 145 * 1024;
constexpr int NPH = 10;

constexpr size_t MiB = 1u << 20, KiB = 1u << 10;
constexpr size_t WS_CTL = 0;
constexpr size_t WS_RSTDX = 1 * MiB;
constexpr size_t WS_RSTDM = WS_RSTDX + 256 * KiB;
constexpr size_t WS_CLS = WS_RSTDM + 64 * KiB;
constexpr size_t WS_WLO = WS_CLS + 256 * KiB;
constexpr size_t WS_WHI = WS_WLO + 256 * KiB;
constexpr size_t WS_RSTD2 = WS_WHI + 256 * KiB;
constexpr size_t WS_HIST = WS_RSTD2 + 256 * KiB;
constexpr size_t WS_TOKPOS = WS_HIST + 64 * KiB;
constexpr size_t WS_WLOS = WS_TOKPOS + 320 * KiB;
constexpr size_t WS_WHIS = WS_WLOS + 320 * KiB;
constexpr size_t WS_RSTDS = WS_WHIS + 320 * KiB;
constexpr size_t WS_TILECLS = WS_RSTDS + 320 * KiB;
constexpr size_t WS_WR = WS_TILECLS + 64 * KiB;
constexpr size_t WS_SMALL_END = WS_WR + 128 * KiB;
static_assert(WS_SMALL_END <= 4 * MiB, "small region");
constexpr size_t WS_LORA = 4 * MiB;
constexpr size_t LORA_STRIDE = 256 * KiB;
constexpr size_t WS_WR2 = 5 * MiB, WR_STRIDE = 256 * KiB;
constexpr size_t WS_SSQ = 6 * MiB;
constexpr size_t WS_SSQ2 = 7 * MiB;
constexpr size_t WS_W = 8 * MiB, W_STRIDE = 60 * MiB;
constexpr size_t W_IN = 0;
constexpr size_t W_MEM = W_IN + (size_t)PINP * DM * 2;
constexpr size_t W_OUT = W_MEM + (size_t)512 * DM * 2;
constexpr size_t W_GU = W_OUT + (size_t)DM * DM * 2;
constexpr size_t W_DN = W_GU + (size_t)16 * DM * DM * 2;
constexpr size_t W_END = W_DN + (size_t)16 * DM * 512 * 2;
static_assert(W_END <= 60 * MiB, "weights region");
constexpr size_t WS_MEMB = WS_W + 120 * MiB;
constexpr size_t WS_MEMKV = WS_MEMB + 4 * MiB;
constexpr size_t DO_MIX = 0, DO_XB = 128 * MiB;
constexpr size_t WS_PA = WS_MEMKV + 2 * MiB;
constexpr size_t WS_PR = WS_PA + 224 * MiB;
constexpr size_t WS_CH = WS_PR + 160 * MiB;
constexpr size_t WS_XB2 = WS_PA;
constexpr size_t WS_H = WS_CH;
constexpr size_t WS_RW = WS_CH + 320 * MiB;
constexpr size_t RWB = (size_t)NT * 256 * 2;
constexpr size_t WS_Y = WS_RW + 3 * RWB;
constexpr size_t WS_END = WS_RW + 5 * RWB;
static_assert((size_t)MPAD * DM * 2 <= 320 * MiB, "H fits");
static_assert((size_t)NT * PA_LD * 2 <= 224 * MiB && (size_t)NT * PR_LD * 2 <= 320 * MiB, "P fits");

__device__ __forceinline__ float bf2f(bf16_t v) { return __uint_as_float(((unsigned)v) << 16); }
typedef __bf16 hwbf16x2 __attribute__((ext_vector_type(2)));
__device__ __forceinline__ bf16_t f2bf(float f) { return __builtin_bit_cast(bf16_t, (__bf16)f); }
__device__ __forceinline__ unsigned pk2(float lo, float hi) { hwbf16x2 v; v.x = (__bf16)lo; v.y = (__bf16)hi; return __builtin_bit_cast(unsigned, v); }
__device__ __forceinline__ float bflo(unsigned u) { return __uint_as_float(u << 16); }
__device__ __forceinline__ float bfhi(unsigned u) { return __uint_as_float(u & 0xffff0000u); }
__device__ __forceinline__ void unpack8(const u32x4 v, float* f) { f[0] = bflo(v.x); f[1] = bfhi(v.x); f[2] = bflo(v.y); f[3] = bfhi(v.y); f[4] = bflo(v.z); f[5] = bfhi(v.z); f[6] = bflo(v.w); f[7] = bfhi(v.w); }
__device__ __forceinline__ bf16x8 pack8(const float* f) { u32x4 w; w.x = pk2(f[0], f[1]); w.y = pk2(f[2], f[3]); w.z = pk2(f[4], f[5]); w.w = pk2(f[6], f[7]); return __builtin_bit_cast(bf16x8, w); }
__device__ __forceinline__ float wave_sum(float v) {
#pragma unroll
    for (int o = 32; o >= 1; o >>= 1) v += __shfl_xor(v, o);
    return v;
}
__device__ __forceinline__ float sigmoidf_(float x) { return __builtin_amdgcn_rcpf(1.0f + __expf(-x)); }

#define XB_TMO      128
#define XB_XCNT(j)  (256  + 64 * (j))
#define XB_XSUB(j)  (1280 + 64 * (j))
#define XB_XGEN(j)  (2304 + 64 * (j))
#define XB_TOP      3328
#define XB_TOPGEN   3392
#define XCD_BAR_WORDS 3456
#define XB_SPIN_CAP (1u << 18)

__device__ __forceinline__ unsigned xb_ld(unsigned* p)              { return __hip_atomic_load(p, __ATOMIC_RELAXED, __HIP_MEMORY_SCOPE_AGENT); }
__device__ __forceinline__ unsigned xb_add(unsigned* p, unsigned v) { return __hip_atomic_fetch_add(p, v, __ATOMIC_RELAXED, __HIP_MEMORY_SCOPE_AGENT); }
__device__ __forceinline__ unsigned xb_xcc_id() { return (unsigned)__builtin_amdgcn_s_getreg((3 << 11) | 20) & 0xFu; }
#define XB_SPIN(cond, bar) do { unsigned _sp = 0; while (cond) { __builtin_amdgcn_s_sleep(1); \
    if ((++_sp & 255u) == 0u) { if (xb_ld(&(bar)[XB_TMO])) break; if (_sp > XB_SPIN_CAP) { atomicAdd(&(bar)[XB_TMO], 1u); break; } } } } while (0)

struct XcdBarrier { unsigned* bar; unsigned x; volatile LAS unsigned* st; };

__device__ __forceinline__ XcdBarrier xcd_barrier_post(unsigned* bar, volatile LAS unsigned* st, bool leader  ) {
    XcdBarrier b; b.bar = bar; b.x = xb_xcc_id(); b.st = st;
    if (leader) (void)xb_add(&bar[XB_XCNT(b.x)], 1u);
    return b;
}
__device__ __forceinline__ void xcd_barrier_complete(unsigned* bar, unsigned x, unsigned& nloc, unsigned& nx) {
    const unsigned G = gridDim.x * gridDim.y * gridDim.z;
    unsigned sum, cnt, mine, sp = 0u;
    for (;;) {
        sum = 0u; cnt = 0u; mine = 0u;
#pragma unroll
        for (unsigned j = 0; j < 16; ++j) { const unsigned c = xb_ld(&bar[XB_XCNT(j)]); sum += c; cnt += (c > 0u) ? 1u : 0u; mine = (j == x) ? c : mine; }
        if (sum == G) break;
        __builtin_amdgcn_s_sleep(1);
        if ((++sp & 255u) == 0u) { if (xb_ld(&bar[XB_TMO])) break; if (sp > XB_SPIN_CAP) { atomicAdd(&bar[XB_TMO], 1u); break; } }
    }
    nloc = mine > 0u ? mine : 1u; nx = cnt > 0u ? cnt : 1u;
}
__device__ __forceinline__ void xcd_barrier(const XcdBarrier& b, bool leader  ) {
    asm volatile("s_waitcnt vmcnt(0)" ::: "memory");
    __syncthreads();
    if (leader) {
        unsigned* bar = b.bar;
        __builtin_amdgcn_s_waitcnt(0);
        unsigned nloc = b.st[0], nx = b.st[1];
        if (nloc == 0u) { xcd_barrier_complete(bar, b.x, nloc, nx); b.st[0] = nloc; b.st[1] = nx; }
        const unsigned old = xb_add(&bar[XB_XSUB(b.x)], 1u);
        const unsigned gen = old / nloc;
        if (old + 1u == (gen + 1u) * nloc) {
            __builtin_amdgcn_fence(__ATOMIC_RELEASE, "agent");
            asm volatile("s_waitcnt vmcnt(0)" ::: "memory");
            const unsigned og = xb_add(&bar[XB_TOP], 1u);
            const unsigned tg = og / nx;
            if (og + 1u == (tg + 1u) * nx) xb_add(&bar[XB_TOPGEN], 1u);
            else XB_SPIN(xb_ld(&bar[XB_TOPGEN]) == tg, bar);
            __builtin_amdgcn_fence(__ATOMIC_ACQUIRE, "agent");
            xb_add(&bar[XB_XGEN(b.x)], 1u);
            asm volatile("s_waitcnt vmcnt(0)" ::: "memory");
        } else {
            XB_SPIN(xb_ld(&bar[XB_XGEN(b.x)]) == gen, bar);
            __builtin_amdgcn_fence(__ATOMIC_ACQUIRE, "agent");
            asm volatile("s_waitcnt vmcnt(0)" ::: "memory");
        }
    }
    __syncthreads();
}

struct Args {
    const float* tab[34];
    int ph_lo, ph_hi;
};
typedef const float* cfp_t;
typedef __attribute__((address_space(4))) const cfp_t* InTab;
struct Frame {
    InTab in;
    float* out;
    unsigned char* ws;
    LAS unsigned char* lds;
    int tid, lane, wave, bid, dup;
};
__device__ __forceinline__ uintptr_t launder_uniform(uintptr_t p) {
    unsigned lo = (unsigned)p, hi = (unsigned)(p >> 32);
    asm volatile("" : "+v"(lo), "+v"(hi));
    lo = __builtin_amdgcn_readfirstlane(lo); hi = __builtin_amdgcn_readfirstlane(hi);
    return ((uintptr_t)hi << 32) | (uintptr_t)lo;
}
__device__ __forceinline__ void refresh(Frame& F) {
    int ln; asm volatile("v_mbcnt_lo_u32_b32 %0, -1, 0\n\tv_mbcnt_hi_u32_b32 %0, -1, %0" : "=v"(ln));
    F.lane = ln; F.tid = F.wave * 64 + ln;
    F.in = (InTab)launder_uniform((uintptr_t)__builtin_amdgcn_kernarg_segment_ptr());
    F.out = (float*)F.in[32]; F.ws = (unsigned char*)F.in[33];
}

namespace g8 {
constexpr int BM = 256, BK = 64, HALF = 128, HTB = HALF * BK * 2, NXCD = 8, WGM = 8;
__device__ __forceinline__ int lds_byte(int r, int c) { const int st = (r >> 4) * 2 + (c >> 5), rr = r & 15, cc = c & 31, ob = rr * 64 + cc * 2; return st * 1024 + (ob ^ (((ob >> 9) & 1) << 5)); }
__device__ __forceinline__ void stage_rc(int b, int& R, int& C) { const int st = b / 1024, sb = b % 1024, swz = sb ^ (((sb >> 9) & 1) << 5); R = (st >> 1) * 16 + swz / 64; C = (st & 1) * 32 + (swz % 64) / 2; }

struct Unit { int pm, pn; };
struct StaticOrder {
    int nM, nN, nwg, G, c;
    __device__ void init(int nM_, int nN_, int G_, int c_) { nM = nM_; nN = nN_; nwg = nM * nN; G = G_; c = c_; }
    __device__ bool next(int i, Unit& u) const {
        const long L = (long)i * G + c; if (L >= nwg) return false;
        int wgid = (int)L; { const int q = nwg / NXCD, r = nwg % NXCD, xcd = wgid % NXCD, off = wgid / NXCD; wgid = (xcd < r ? xcd * (q + 1) : r * (q + 1) + (xcd - r) * q) + off; }
        const int nig = WGM * nN, gid = wgid / nig, fm = gid * WGM, gsz = (nM - fm) < WGM ? (nM - fm) : WGM;
        u.pm = fm + ((wgid % nig) % gsz); u.pn = (wgid % nig) / gsz; return true;
    }
};

struct GemmIn {
    __amdgpu_buffer_rsrc_t rA, rB0, rB1;
    unsigned sA, hstepA;
    unsigned va[2];
    unsigned vg[2][2];
    unsigned sB0, sB1, hstepB; int ksplit;
    unsigned vb[2];
};
#define G8_RSRC(p) __builtin_amdgcn_make_buffer_rsrc((void*)(p), (short)0, 0x7fffffff, 0x00020000)

#define G8_WAIT_V(n) asm volatile("s_waitcnt vmcnt(" #n ")" ::: "memory")
#define G8_WAIT_L(n) asm volatile("s_waitcnt lgkmcnt(" #n ")" ::: "memory")
#define G8_BAR __builtin_amdgcn_s_barrier()
#define G8_SCHED __builtin_amdgcn_sched_barrier(0)

template <bool GATHER, class Epi>
__device__ __forceinline__ void gemm_unit(LAS unsigned char* lds, int wave_s, int lane_v, const GemmIn& gi, const Epi& epi) {
    constexpr int nt = 16;
    constexpr unsigned kstep = BK * 2;
    const int wid = wave_s, lane = lane_v, wr = wid >> 2, wc = wid & 3, fr = lane & 15, fq = lane >> 4;
    const unsigned ldsw = (unsigned)wid * 1024u;
    const int aoff = lds_byte(wr * 64 + fr, fq * 8), boff = lds_byte(wc * 32 + fr, fq * 8);
#define SA(b, h) (((b) * 2 + (h)) * HTB)
#define SB(b, h) ((4 + (b) * 2 + (h)) * HTB)
#define STAGE(bufoff, rsrc, voff, soff) do { _Pragma("unroll") for (int _i = 0; _i < 2; ++_i) \
        __builtin_amdgcn_raw_ptr_buffer_load_lds(rsrc, (LAS unsigned*)(lds + (bufoff) + ldsw + _i * 8192), 16, (voff)[_i], soff, 0, 0); } while (0)
#define STA(b, h, kt) do { if constexpr (GATHER) STAGE(SA(b, h), gi.rA, gi.vg[h], gi.sA + (unsigned)(kt) * kstep); \
        else STAGE(SA(b, h), gi.rA, gi.va, gi.sA + (h) * gi.hstepA + (unsigned)(kt) * kstep); } while (0)
#define STB(b, h, kt) do { const bool _f = (kt) < gi.ksplit; STAGE(SB(b, h), _f ? gi.rB0 : gi.rB1, gi.vb, (_f ? gi.sB0 + (unsigned)(kt) * kstep : gi.sB1 + (unsigned)((kt) - gi.ksplit) * kstep) + (h) * gi.hstepB); } while (0)
#define LDA(dst, b, h) do { _Pragma("unroll") for (int m = 0; m < 4; ++m) _Pragma("unroll") for (int k = 0; k < 2; ++k) dst[m][k] = *(const LAS bf16x8*)(lds + SA(b, h) + aoff + m * 2048 + k * 1024); } while (0)
#define LDB(dst, b, h) do { _Pragma("unroll") for (int n = 0; n < 2; ++n) _Pragma("unroll") for (int k = 0; k < 2; ++k) dst[n][k] = *(const LAS bf16x8*)(lds + SB(b, h) + boff + n * 2048 + k * 1024); } while (0)
#define MMA(ai, bj, At_, Bt_) do { __builtin_amdgcn_s_setprio(1); \
        _Pragma("unroll") for (int m = 0; m < 4; ++m) _Pragma("unroll") for (int n = 0; n < 2; ++n) _Pragma("unroll") for (int k = 0; k < 2; ++k) \
            acc[ai][bj][m][n] = __builtin_amdgcn_mfma_f32_16x16x32_bf16(Bt_[n][k], At_[m][k], acc[ai][bj][m][n], 0, 0, 0); \
        __builtin_amdgcn_s_setprio(0); } while (0)

    f32x4 acc[2][2][4][2];
    { float z = 0.f; asm volatile("" : "+v"(z));
#pragma unroll
    for (int a = 0; a < 2; ++a)
#pragma unroll
        for (int b = 0; b < 2; ++b)
#pragma unroll
            for (int m = 0; m < 4; ++m)
#pragma unroll
                for (int n = 0; n < 2; ++n) acc[a][b][m][n] = (f32x4){z, z, z, z}; }
    bf16x8 At[4][2], B0[2][2], B1[2][2];
#if KLOOP_REP > 1
    for (int rep_ = 0; rep_ < KLOOP_REP; ++rep_) {
    if (rep_) { float z = 0.f; asm volatile("" : "+v"(z));
#pragma unroll
    for (int a = 0; a < 2; ++a)
#pragma unroll
        for (int b = 0; b < 2; ++b)
#pragma unroll
            for (int m = 0; m < 4; ++m)
#pragma unroll
                for (int n = 0; n < 2; ++n) acc[a][b][m][n] = (f32x4){z, z, z, z}; }
#endif
    float pre_v[4]; epi.pre_load(wid * 64 + lane, pre_v);
    STB(0, 0, 0); STA(0, 0, 0); STB(0, 1, 0); STA(0, 1, 0);
    if (wr == 1) G8_BAR;
    G8_WAIT_V(4); G8_BAR;
    epi.pre_commit(lds, wid * 64 + lane, pre_v);
    STB(1, 0, 1); STA(1, 0, 1); STB(1, 1, 1);
    G8_WAIT_V(6); G8_BAR;
    for (int t = 0; t < nt - 2; t += 2) {
        LDB(B0, 0, 0); G8_SCHED; LDA(At, 0, 0); STA(1, 1, t + 1);
        G8_WAIT_L(8); G8_BAR; G8_WAIT_L(0); MMA(0, 0, At, B0); G8_BAR; G8_SCHED;
        LDB(B1, 0, 1); STB(0, 0, t + 2);
        G8_BAR; G8_WAIT_L(0); MMA(0, 1, At, B1); G8_BAR;
        LDA(At, 0, 1); STA(0, 0, t + 2);
        G8_BAR; G8_WAIT_L(0); MMA(1, 0, At, B0); G8_BAR; G8_SCHED;
        STB(0, 1, t + 2);
        G8_WAIT_V(6); G8_BAR; MMA(1, 1, At, B1); G8_BAR;
        LDB(B0, 1, 0); G8_SCHED; LDA(At, 1, 0); STA(0, 1, t + 2);
        G8_WAIT_L(8); G8_BAR; G8_WAIT_L(0); MMA(0, 0, At, B0); G8_BAR; G8_SCHED;
        LDB(B1, 1, 1); STB(1, 0, t + 3);
        G8_BAR; G8_WAIT_L(0); MMA(0, 1, At, B1); G8_BAR;
        LDA(At, 1, 1); STA(1, 0, t + 3);
        G8_BAR; G8_WAIT_L(0); MMA(1, 0, At, B0); G8_BAR; G8_SCHED;
        STB(1, 1, t + 3);
        G8_WAIT_V(6); G8_BAR; MMA(1, 1, At, B1); G8_BAR;
    }
    { LDB(B0, 0, 0); G8_WAIT_V(0); LDA(At, 0, 0); STA(1, 1, nt - 1);
      G8_BAR; G8_WAIT_L(0); MMA(0, 0, At, B0); G8_BAR;
      LDB(B1, 0, 1); G8_BAR; G8_WAIT_L(0); MMA(0, 1, At, B1); G8_BAR;
      LDA(At, 0, 1); G8_WAIT_V(4); G8_BAR; G8_WAIT_L(0); MMA(1, 0, At, B0); MMA(1, 1, At, B1); G8_BAR; }
    { LDB(B0, 1, 0); LDA(At, 1, 0); G8_WAIT_V(2); G8_BAR; G8_WAIT_L(0); MMA(0, 0, At, B0); G8_BAR;
      LDB(B1, 1, 1); G8_WAIT_V(0); G8_BAR; G8_WAIT_L(0); MMA(0, 1, At, B1); G8_BAR;
      LDA(At, 1, 1); G8_BAR; G8_WAIT_L(0); MMA(1, 0, At, B0); MMA(1, 1, At, B1); G8_BAR; }
    if (wr == 0) G8_BAR;
#if KLOOP_REP > 1
    }
#endif
    { int lane2; asm volatile("v_mbcnt_lo_u32_b32 %0, -1, 0\n\tv_mbcnt_hi_u32_b32 %0, -1, %0" : "=v"(lane2));
      epi(acc, wid >> 2, wid & 3, lane2 & 15, lane2 >> 4, lds);
#if EPI_REP > 1
      if (Epi::REPEATABLE) { G8_WAIT_V(0); epi(acc, wid >> 2, wid & 3, lane2 & 15, lane2 >> 4, lds); }
#endif
    }
    G8_WAIT_V(0);
#undef SA
#undef SB
#undef STAGE
#undef STA
#undef STB
#undef LDA
#undef LDB
#undef MMA
}

template <bool GATHER, class Prob>
__device__ __forceinline__ void gemm_phase(LAS unsigned char* lds, int wave_s, int lane_v, const Prob& pb) {
    constexpr int nt = 16;
    constexpr unsigned kstep = BK * 2;
    const int wid = wave_s, lane = lane_v, wr = wid >> 2, wc = wid & 3, fr = lane & 15, fq = lane >> 4;
    const unsigned ldsw = (unsigned)wid * 1024u;
    const int aoff = lds_byte(wr * 64 + fr, fq * 8), boff = lds_byte(wc * 32 + fr, fq * 8);
#define SA(b, h) (((b) * 2 + (h)) * HTB)
#define SB(b, h) ((4 + (b) * 2 + (h)) * HTB)
#define STAGE(bufoff, rsrc, voff, soff) do { _Pragma("unroll") for (int _i = 0; _i < 2; ++_i) \
        __builtin_amdgcn_raw_ptr_buffer_load_lds(rsrc, (LAS unsigned*)(lds + (bufoff) + ldsw + _i * 8192), 16, (voff)[_i], soff, 0, 0); } while (0)
#define STA(gi, b, h, kt) do { if constexpr (GATHER) STAGE(SA(b, h), (gi).rA, (gi).vg[h], (gi).sA + (unsigned)(kt) * kstep); \
        else STAGE(SA(b, h), (gi).rA, (gi).va, (gi).sA + (h) * (gi).hstepA + (unsigned)(kt) * kstep); } while (0)
#define STB(gi, b, h, kt) do { const bool _f = (kt) < (gi).ksplit; STAGE(SB(b, h), _f ? (gi).rB0 : (gi).rB1, (gi).vb, (_f ? (gi).sB0 + (unsigned)(kt) * kstep : (gi).sB1 + (unsigned)((kt) - (gi).ksplit) * kstep) + (h) * (gi).hstepB); } while (0)
#define LDA(dst, b, h) do { _Pragma("unroll") for (int m = 0; m < 4; ++m) _Pragma("unroll") for (int k = 0; k < 2; ++k) dst[m][k] = *(const LAS bf16x8*)(lds + SA(b, h) + aoff + m * 2048 + k * 1024); } while (0)
#define LDB(dst, b, h) do { _Pragma("unroll") for (int n = 0; n < 2; ++n) _Pragma("unroll") for (int k = 0; k < 2; ++k) dst[n][k] = *(const LAS bf16x8*)(lds + SB(b, h) + boff + n * 2048 + k * 1024); } while (0)
#define MMA(ai, bj, At_, Bt_) do { __builtin_amdgcn_s_setprio(1); \
        _Pragma("unroll") for (int m = 0; m < 4; ++m) _Pragma("unroll") for (int n = 0; n < 2; ++n) _Pragma("unroll") for (int k = 0; k < 2; ++k) \
            acc[ai][bj][m][n] = __builtin_amdgcn_mfma_f32_16x16x32_bf16(Bt_[n][k], At_[m][k], acc[ai][bj][m][n], 0, 0, 0); \
        __builtin_amdgcn_s_setprio(0); } while (0)
#define ZERO_ACC() do { float z = 0.f; asm volatile("" : "+v"(z)); \
        _Pragma("unroll") for (int a = 0; a < 2; ++a) _Pragma("unroll") for (int b = 0; b < 2; ++b) _Pragma("unroll") for (int m = 0; m < 4; ++m) _Pragma("unroll") for (int n = 0; n < 2; ++n) acc[a][b][m][n] = (f32x4){z, z, z, z}; } while (0)
    Unit cur, nxt;
    if (!pb.next(0, cur)) return;
    GemmIn gc, gn; pb.setup(cur, gc);
    f32x4 acc[2][2][4][2];
    ZERO_ACC();
    bf16x8 At[4][2], B0[2][2], B1[2][2];
    STB(gc, 0, 0, 0); STA(gc, 0, 0, 0); STB(gc, 0, 1, 0); STA(gc, 0, 1, 0);
    if (wr == 1) G8_BAR;
    G8_WAIT_V(4); G8_BAR;
    STB(gc, 1, 0, 1); STA(gc, 1, 0, 1); STB(gc, 1, 1, 1);
    G8_WAIT_V(6); G8_BAR;
    for (int ui = 0;; ++ui) {
        const bool has_next = pb.next(ui + 1, nxt);
        if (has_next) pb.setup(nxt, gn); else gn = gc;
        for (int t = 0; t < nt; t += 2) {
            const bool last = (t == nt - 2);
            const GemmIn g2 = last ? gn : gc;
            const int k2 = last ? 0 : t + 2, k3 = k2 + 1;
            LDB(B0, 0, 0); G8_SCHED; LDA(At, 0, 0); STA(gc, 1, 1, t + 1);
            G8_WAIT_L(8); G8_BAR; G8_WAIT_L(0); MMA(0, 0, At, B0); G8_BAR; G8_SCHED;
            LDB(B1, 0, 1); STB(g2, 0, 0, k2);
            G8_BAR; G8_WAIT_L(0); MMA(0, 1, At, B1); G8_BAR;
            LDA(At, 0, 1); STA(g2, 0, 0, k2);
            G8_BAR; G8_WAIT_L(0); MMA(1, 0, At, B0); G8_BAR; G8_SCHED;
            STB(g2, 0, 1, k2);
            G8_WAIT_V(6); G8_BAR; MMA(1, 1, At, B1); G8_BAR;
            LDB(B0, 1, 0); G8_SCHED; LDA(At, 1, 0); STA(g2, 0, 1, k2);
            G8_WAIT_L(8); G8_BAR; G8_WAIT_L(0); MMA(0, 0, At, B0); G8_BAR; G8_SCHED;
            LDB(B1, 1, 1); STB(g2, 1, 0, k3);
            G8_BAR; G8_WAIT_L(0); MMA(0, 1, At, B1); G8_BAR;
            LDA(At, 1, 1); STA(g2, 1, 0, k3);
            G8_BAR; G8_WAIT_L(0); MMA(1, 0, At, B0); G8_BAR; G8_SCHED;
            STB(g2, 1, 1, k3);
            G8_WAIT_V(6); G8_BAR; MMA(1, 1, At, B1); G8_BAR;
        }
        { int lane2; asm volatile("v_mbcnt_lo_u32_b32 %0, -1, 0\n\tv_mbcnt_hi_u32_b32 %0, -1, %0" : "=v"(lane2));
          pb.epi(cur)(acc, wid >> 2, wid & 3, lane2 & 15, lane2 >> 4, lds); }
        if (!has_next) break;
        ZERO_ACC();
        cur = nxt; gc = gn;
    }
    G8_WAIT_V(0);
    if (wr == 0) G8_BAR;
    G8_BAR;
#undef SA
#undef SB
#undef STAGE
#undef STA
#undef STB
#undef LDA
#undef LDB
#undef MMA
#undef ZERO_ACC
}

template <bool GATHER, class Prob>
__device__ __forceinline__ void gemm_units(LAS unsigned char* lds, int wave_s, int lane_v, const Prob& pb) {
    Unit u;
    for (int i = 0; pb.next(i, u); ++i) { GemmIn gi; pb.setup(u, gi); gemm_unit<GATHER>(lds, wave_s, lane_v, gi, pb.epi(u)); }
}
template <bool GATHER, class Prob>
__device__ __forceinline__ void gemm_units_dyn(LAS unsigned char* lds, int wave_s, int lane_v, const Prob& pb, unsigned* counter, int nM, int nN) {
    volatile LAS int* slot = (volatile LAS int*)(lds + LDS_MISC + 64);
    const int total = nM * nN;
    for (;;) {
        if (wave_s == 0 && lane_v == 0) *slot = (int)__hip_atomic_fetch_add(counter, 1u, __ATOMIC_RELAXED, __HIP_MEMORY_SCOPE_AGENT);
        __syncthreads();
        const int k = *slot;
        __syncthreads();
        if (k >= total) break;
        Unit u; u.pm = k / nN; u.pn = k - u.pm * nN;
        GemmIn gi; pb.setup(u, gi); gemm_unit<GATHER>(lds, wave_s, lane_v, gi, pb.epi(u));
    }
}
__device__ __forceinline__ void stage_coords(int tid, int& R0, int& R1, int& C) { int c1; stage_rc(tid * 16, R0, C); stage_rc(tid * 16 + 8192, R1, c1); }
__device__ __forceinline__ void stage_coords_now(int wave, int& R0, int& R1, int& C) {
    int ln; asm volatile("v_mbcnt_lo_u32_b32 %0, -1, 0\n\tv_mbcnt_hi_u32_b32 %0, -1, %0" : "=v"(ln));
    stage_coords(wave * 64 + ln, R0, R1, C);
}
__device__ __forceinline__ void set_A_rows(GemmIn& gi, const bf16_t* A, int row0, int lda, int R0, int R1, int C) {
    gi.rA = G8_RSRC(A); gi.sA = (unsigned)row0 * (unsigned)lda * 2u; gi.hstepA = 128u * (unsigned)lda * 2u;
    gi.va[0] = (unsigned)(R0 * lda + C) * 2u; gi.va[1] = (unsigned)(R1 * lda + C) * 2u;
    gi.vg[0][0] = gi.va[0]; gi.vg[0][1] = gi.va[1]; gi.vg[1][0] = gi.va[0]; gi.vg[1][1] = gi.va[1];
}
__device__ __forceinline__ void set_B(GemmIn& gi, const bf16_t* B0, const bf16_t* B1, unsigned row0_0, unsigned row0_1, int ksplit, int ldb, int R0, int R1, int C) {
    gi.rB0 = G8_RSRC(B0); gi.rB1 = G8_RSRC(B1); gi.sB0 = row0_0 * (unsigned)ldb * 2u; gi.sB1 = row0_1 * (unsigned)ldb * 2u; gi.ksplit = ksplit; gi.hstepB = 128u * (unsigned)ldb * 2u;
    gi.vb[0] = (unsigned)(R0 * ldb + C) * 2u; gi.vb[1] = (unsigned)(R1 * ldb + C) * 2u;
}
constexpr int EP_PB = 528, EP_PH = 272, EP_PF = 1040;
template <int PARTS> struct EpiScaleBf16 {
    static constexpr bool REPEATABLE = true;
    bf16_t* O; int ld, ncols; const float* rstd; int row0, col0;
    __device__ __forceinline__ void pre_load(int t, float (&v)[4]) const { const int row = row0 + (t & 255);
        if (PARTS == 1) { v[0] = rstd[row]; v[1] = v[2] = v[3] = 0.f; }
        else { v[0] = rstd[row]; v[1] = rstd[(size_t)NT + row]; v[2] = rstd[(size_t)2 * NT + row]; v[3] = rstd[(size_t)3 * NT + row]; } }
    __device__ __forceinline__ void pre_commit(LAS unsigned char* lds, int t, const float (&v)[4]) const {
        if (t < 256) *(LAS float*)(lds + LDS_RPB + t * 4) = PARTS == 1 ? v[0] : rsqrtf(((v[0] + v[1]) + (v[2] + v[3])) * (1.0f / DM) + 1e-6f); }
    __device__ __forceinline__ void operator()(const f32x4 (&acc)[2][2][4][2], int wr, int wc, int fr, int fq, LAS unsigned char* lds) const {
        float rs[2][4];
#pragma unroll
        for (int ai = 0; ai < 2; ++ai)
#pragma unroll
            for (int m = 0; m < 4; ++m) rs[ai][m] = *(const LAS float*)(lds + LDS_RPB + (ai * HALF + wr * 64 + m * 16 + fr) * 4);
        const int t = (wr * 4 + wc) * 64 + fq * 16 + fr;
#pragma unroll
        for (int ai = 0; ai < 2; ++ai) {
#pragma unroll
            for (int m = 0; m < 4; ++m)
#pragma unroll
                for (int bj = 0; bj < 2; ++bj)
#pragma unroll
                    for (int n = 0; n < 2; ++n) { const f32x4 v = acc[ai][bj][m][n] * rs[ai][m]; u32x2 w; w.x = pk2(v[0], v[1]); w.y = pk2(v[2], v[3]);
                        *(LAS u32x2*)(lds + (wr * 64 + m * 16 + fr) * EP_PB + (bj * HALF + wc * 32 + n * 16 + 4 * fq) * 2) = w; }
            __syncthreads();
#pragma unroll
            for (int p = 0; p < 8; ++p) { const int rl = p * 16 + (t >> 5), ch = t & 31, col = col0 + ch * 8;
                if (col < ncols) *(u32x4*)(O + (size_t)(row0 + ai * HALF + rl) * ld + col) = *(const LAS u32x4*)(lds + rl * EP_PB + ch * 16); }
            __syncthreads();
        }
    }
};
struct EpiGateUp {
    static constexpr bool REPEATABLE = true;
    bf16_t* H; const float* rstds; const float* wsel; int row0, colh0;
    __device__ __forceinline__ void pre_load(int t, float (&v)[4]) const { v[0] = rstds[row0 + (t & 255)]; v[1] = wsel[row0 + (t & 255)]; v[2] = v[3] = 0.f; }
    __device__ __forceinline__ void pre_commit(LAS unsigned char* lds, int t, const float (&v)[4]) const { if (t < 256) { *(LAS float*)(lds + LDS_RPB + t * 4) = v[0]; *(LAS float*)(lds + LDS_RPB + 1024 + t * 4) = v[1]; } }
    __device__ __forceinline__ void operator()(const f32x4 (&acc)[2][2][4][2], int wr, int wc, int fr, int fq, LAS unsigned char* lds) const {
        const int t = (wr * 4 + wc) * 64 + fq * 16 + fr;
#pragma unroll
        for (int ai = 0; ai < 2; ++ai)
#pragma unroll
            for (int m = 0; m < 4; ++m) {
                const int rl = ai * HALF + wr * 64 + m * 16 + fr; const float rs = *(const LAS float*)(lds + LDS_RPB + rl * 4), w = *(const LAS float*)(lds + LDS_RPB + 1024 + rl * 4);
#pragma unroll
                for (int n = 0; n < 2; ++n) { f32x4 o;
#pragma unroll
                    for (int j = 0; j < 4; ++j) { const float g = acc[ai][0][m][n][j] * rs, u = acc[ai][1][m][n][j] * rs; o[j] = g * __builtin_amdgcn_rcpf(1.0f + __expf(-g)) * u * w; }
                    u32x2 pw; pw.x = pk2(o[0], o[1]); pw.y = pk2(o[2], o[3]); *(LAS u32x2*)(lds + rl * EP_PH + (wc * 32 + n * 16 + 4 * fq) * 2) = pw; }
            }
        __syncthreads();
#pragma unroll
        for (int p = 0; p < 8; ++p) { const int rl = p * 32 + (t >> 4), ch = t & 15;
            *(u32x4*)(H + (size_t)(row0 + rl) * DM + colh0 + ch * 8) = *(const LAS u32x4*)(lds + rl * EP_PH + ch * 16); }
        __syncthreads();
    }
};
template <bool SCATTER, bool F32OUT> struct EpiResidT {
    static constexpr bool REPEATABLE = false;
    __device__ __forceinline__ void pre_load(int t, float (&v)[4]) const { v[0] = SCATTER ? __int_as_float(tokpos[row0 + (t & 255)]) : 0.f; v[1] = v[2] = v[3] = 0.f; }
    __device__ __forceinline__ void pre_commit(LAS unsigned char* lds, int t, const float (&v)[4]) const { if (SCATTER && t < 256) *(LAS float*)(lds + LDS_RPB + t * 4) = v[0]; }
    const bf16_t* xres; float* out; bf16_t* xo; const int* tokpos; float* ssq; int row0, col0;
    __device__ __forceinline__ void operator()(const f32x4 (&acc)[2][2][4][2], int wr, int wc, int fr, int fq, LAS unsigned char* lds) const {
        const int t = (wr * 4 + wc) * 64 + fq * 16 + fr, ch = t & 63;
#pragma unroll
        for (int hq = 0; hq < 2; ++hq) {
            int rows[16]; u32x2 rw[16];
#pragma unroll
            for (int k = 0; k < 16; ++k) { const int rl = hq * HALF + (k >> 3) * 64 + (k & 7) * 8 + (t >> 6); rows[k] = SCATTER ? *(const LAS int*)(lds + LDS_RPB + rl * 4) : row0 + rl; }
#pragma unroll
            for (int k = 0; k < 16; ++k) rw[k] = *(const u32x2*)(xres + (size_t)(rows[k] < 0 ? 0 : rows[k]) * DM + col0 + ch * 4);
#pragma unroll
            for (int qq = 0; qq < 2; ++qq) {
                if (wr == qq) {
#pragma unroll
                    for (int m = 0; m < 4; ++m)
#pragma unroll
                        for (int bj = 0; bj < 2; ++bj)
#pragma unroll
                            for (int n = 0; n < 2; ++n) *(LAS f32x4*)(lds + (m * 16 + fr) * EP_PF + (bj * HALF + wc * 32 + n * 16 + 4 * fq) * 4) = acc[hq][bj][m][n];
                }
                __syncthreads();
#pragma unroll
                for (int p = 0; p < 8; ++p) { const int k = qq * 8 + p, rl = p * 8 + (t >> 6), row = rows[k];
                    if (!SCATTER || row >= 0) { const size_t o = (size_t)row * DM + col0 + ch * 4;
                        const f32x4 r4 = {__uint_as_float(rw[k].x << 16), __uint_as_float(rw[k].x & 0xffff0000u), __uint_as_float(rw[k].y << 16), __uint_as_float(rw[k].y & 0xffff0000u)};
                        const f32x4 v = r4 + *(const LAS f32x4*)(lds + rl * EP_PF + ch * 16);
                        if (F32OUT) *(f32x4*)(out + o) = v;
                        else { u32x2 w; w.x = pk2(v[0], v[1]); w.y = pk2(v[2], v[3]); *(u32x2*)(xo + o) = w;
                            if (ssq) { float s2 = (v[0] * v[0] + v[1] * v[1]) + (v[2] * v[2] + v[3] * v[3]); s2 = wave_sum(s2); if (ch == 0) ssq[(size_t)(col0 >> 8) * NT + row] = s2; } } } }
                __syncthreads();
            }
        }
    }
};
typedef EpiResidT<false, false> EpiResid;
}

#define WSP(T, off) ((T*)(F.ws + (off)))
#define RWBUF(i) ((bf16_t*)(F.ws + WS_RW + (size_t)((i) == 3 ? 0 : ((i) == 8 ? 1 : 2)) * RWB))

struct TJob { const float* src; int sld; bf16_t* dst; int dld; const float* scale; };
struct TRaw { f32x4 v0, v1; float s0, s1; };
__device__ __forceinline__ void tjob_fetch(const TJob& jb, int tid, TRaw& r) {
    const int kk = tid >> 4, c4 = (tid & 15) * 4;
    r.v0 = *(const f32x4*)(jb.src + (size_t)kk * jb.sld + c4); r.v1 = *(const f32x4*)(jb.src + (size_t)(kk + 32) * jb.sld + c4);
    r.s0 = jb.scale ? jb.scale[kk] : 1.0f; r.s1 = jb.scale ? jb.scale[kk + 32] : 1.0f;
}
__device__ __forceinline__ void tjob_to_lds(LAS float* T, int tid, const TRaw& r) {
    const int kk = tid >> 4, c4 = (tid & 15) * 4;
#pragma unroll
    for (int e = 0; e < 4; ++e) { T[kk * 65 + c4 + e] = r.v0[e] * r.s0; T[(kk + 32) * 65 + c4 + e] = r.v1[e] * r.s1; }
}
__device__ __forceinline__ void row_prep(const float* src, bf16_t* dstb, float* rstd, int row, int lane, bool as_rstd) {
    const f32x4* s = (const f32x4*)(src + (size_t)row * DM); u32x2* d = (u32x2*)(dstb + (size_t)row * DM); float ss = 0.f;
#pragma unroll
    for (int i = 0; i < 4; ++i) { const f32x4 v = s[i * 64 + lane]; ss += v[0] * v[0] + v[1] * v[1] + v[2] * v[2] + v[3] * v[3]; u32x2 w; w.x = pk2(v[0], v[1]); w.y = pk2(v[2], v[3]); d[i * 64 + lane] = w; }
    ss = wave_sum(ss);
    if (lane == 0) rstd[row] = as_rstd ? rsqrtf(ss * (1.0f / DM) + 1e-6f) : ss;
}
__device__ __forceinline__ void weight_prep(Frame& F, int l, int b0, int nb) {
    const int vb = (int)launder_uniform((uintptr_t)(unsigned)(F.bid - b0));
    bf16_t* WB = WSP(bf16_t, WS_W + (size_t)l * W_STRIDE);
    bf16_t* WinT = WB + W_IN / 2; bf16_t* WmemT = WB + W_MEM / 2; bf16_t* WoutT = WB + W_OUT / 2; bf16_t* WguT = WB + W_GU / 2; bf16_t* WdT = WB + W_DN / 2;
    const float* w_in = F.in[3] + (size_t)l * DM * PIN; const float* attn_nw = F.in[2] + l * DM;
    const float* w_mem = F.in[20] + (size_t)l * DM * 512; const float* mem_nw = F.in[19] + l * DM;
    const float* w_out = F.in[23] + (size_t)l * DM * DM; const float* ffn_nw = F.in[24] + l * DM;
    const float* w_gate = F.in[29] + (size_t)l * 16 * DM * 512; const float* w_up = F.in[30] + (size_t)l * 16 * DM * 512; const float* w_down = F.in[31] + (size_t)l * 16 * 512 * DM;
    constexpr int NJ = 736 + 128 + 256 + 4096 + 2048;
#define TDECODE(jx, J) do { int j = (jx); \
        if (j < 736) { const int kt = j & 15, ntl = j >> 4, ntd = ntl < SRC_RW / 64 ? ntl : (ntl < SRC_MQ / 64 ? ntl + 4 : ntl - 18);       \
            J.src = w_in + (size_t)kt * 64 * PIN + ntl * 64; J.sld = PIN; J.dst = WinT + (size_t)ntd * 64 * DM + kt * 64; J.dld = DM; J.scale = attn_nw + kt * 64; } \
        else if (j < 864) { j -= 736; const int kt = j & 15, ntl = j >> 4; J.src = w_mem + (size_t)kt * 64 * 512 + ntl * 64; J.sld = 512; J.dst = WmemT + (size_t)ntl * 64 * DM + kt * 64; J.dld = DM; J.scale = mem_nw + kt * 64; } \
        else if (j < 1120) { j -= 864; const int kt = j & 15, ntl = j >> 4; J.src = w_out + (size_t)kt * 64 * DM + ntl * 64; J.sld = DM; J.dst = WoutT + (size_t)ntl * 64 * DM + kt * 64; J.dld = DM; J.scale = nullptr; } \
        else if (j < 5216) { j -= 1120; const int kt = j & 15, ntl = (j >> 4) & 7, gu = (j >> 7) & 1, e = j >> 8; \
            J.src = (gu ? w_up : w_gate) + (size_t)e * DM * 512 + (size_t)kt * 64 * 512 + ntl * 64; J.sld = 512; \
            J.dst = WguT + ((size_t)e * 1024 + (ntl >> 1) * 256 + gu * 128 + (ntl & 1) * 64) * DM + kt * 64; J.dld = DM; J.scale = ffn_nw + kt * 64; } \
        else { j -= 5216; const int kt = j & 7, ntl = (j >> 3) & 15, e = j >> 7; \
            J.src = w_down + (size_t)e * 512 * DM + (size_t)kt * 64 * DM + ntl * 64; J.sld = DM; J.dst = WdT + ((size_t)e * 1024 + ntl * 64) * 512 + kt * 64; J.dld = 512; J.scale = nullptr; } } while (0)
    if (vb < NJ) {
        LAS float* T = (LAS float*)F.lds;
        TJob cur; TDECODE(vb, cur); TRaw raw; tjob_fetch(cur, F.tid, raw);
        for (int jb = vb; jb < NJ; jb += nb) {
            tjob_to_lds(T, F.tid, raw);
            __syncthreads();
            bf16_t* const cdst = cur.dst; const int cdld = cur.dld;
            const int jn = jb + nb;
            if (jn < NJ) { TDECODE(jn, cur); tjob_fetch(cur, F.tid, raw); }
            { const int n = F.tid >> 3, k8 = (F.tid & 7) * 8; float f[8];
#pragma unroll
              for (int e = 0; e < 8; ++e) f[e] = T[(k8 + e) * 65 + n];
              *(bf16x8*)(cdst + (size_t)n * cdld + k8) = pack8(f); }
            __syncthreads();
        }
    }
#undef TDECODE
    { unsigned z = 0u; asm volatile("" : "+v"(z));
      for (int i = vb * NTHREADS + F.tid; i < 128 * DM / 8; i += nb * NTHREADS) ((u32x4*)(WinT + (size_t)PIN * DM))[i] = (u32x4){z, z, z, z}; }
    { unsigned char* WI = F.ws + WS_WR2 + (size_t)l * WR_STRIDE; const float* wg = F.in[25] + (size_t)l * DM * 4; const float* we = F.in[27] + (size_t)l * DM * 16;
      for (int i = vb * NTHREADS + F.tid; i < 2 * 32 * 64; i += nb * NTHREADS) { const int ln = i & 63, ks = (i >> 6) & 31, nt = i >> 11, o = nt * 16 + (ln & 15), k0 = ks * 32 + 8 * (ln >> 4);
          float v[8], r[8];
#pragma unroll
          for (int e = 0; e < 8; ++e) { const int k = k0 + e; v[e] = o < 4 ? wg[k * 4 + o] * ffn_nw[k] : (o < 20 ? we[k * 16 + (o - 4)] * ffn_nw[k] : 0.f); }
          const u32x4 w = __builtin_bit_cast(u32x4, pack8(v)); unpack8(w, r);
#pragma unroll
          for (int e = 0; e < 8; ++e) r[e] = v[e] - r[e];
          *(u32x4*)(WI + (size_t)i * 16) = w; *(u32x4*)(WI + 65536 + (size_t)i * 16) = __builtin_bit_cast(u32x4, pack8(r)); }
      if (vb == 0 && F.tid < 32) ((float*)(WI + 131072))[F.tid] = F.tid < 4 ? F.in[26][l * 4 + F.tid] : (F.tid < 20 ? F.in[28][l * 16 + F.tid - 4] : 0.f); }
    { bf16_t* W2T = WSP(bf16_t, WS_LORA + (size_t)l * LORA_STRIDE); bf16_t* A2T = W2T + 2 * 256 * 64; bf16_t* G2T = A2T + 2 * 256 * 64;
      const float* w2 = F.in[10] + (size_t)l * 2 * 64 * 256; const float* a2 = F.in[12] + (size_t)l * 2 * 64 * 256; const float* g2 = F.in[13] + (size_t)l * 128 * 256;
      for (int i = vb * NTHREADS + F.tid; i < 2 * 256 * 64; i += nb * NTHREADS) { const int j = i & 63, c = (i >> 6) & 255, d = i >> 14; W2T[i] = f2bf(w2[(size_t)(d * 64 + j) * 256 + c]); A2T[i] = f2bf(a2[(size_t)(d * 64 + j) * 256 + c]); }
      for (int i = vb * NTHREADS + F.tid; i < 256 * 128; i += nb * NTHREADS) { const int j = i & 127, c = i >> 7; G2T[i] = f2bf(g2[(size_t)j * 256 + c]); } }
}
__device__ __forceinline__ void phase_prep(Frame& F, int l) {
    weight_prep(F, 0, 0, GRID);
    float* ssq = WSP(float, WS_SSQ);
    for (int row = F.bid * NWAVES + F.wave; row < NT; row += GRID * NWAVES) { row_prep(F.in[0], (bf16_t*)((char*)F.out + DO_XB), ssq, row, F.lane, false); if (F.lane < 3) ssq[(size_t)(1 + F.lane) * NT + row] = 0.f; }
    for (int row = F.bid * NWAVES + F.wave; row < NMROWS; row += GRID * NWAVES) row_prep(F.in[1], WSP(bf16_t, WS_MEMB), WSP(float, WS_RSTDM), row, F.lane, true);
}

template <int PARTS> struct ProbInproj {
    g8::StaticOrder S; int wave; const bf16_t* A; const bf16_t* Bt; bf16_t* O; bf16_t* O2; const float* rstd; int ld, ncols;
    __device__ __forceinline__ bool next(int i, g8::Unit& u) const { return S.next(i, u); }
    __device__ __forceinline__ void setup(const g8::Unit& u, g8::GemmIn& gi) const { int R0, R1, C; g8::stage_coords_now(wave, R0, R1, C); g8::set_A_rows(gi, A, u.pm * 256, DM, R0, R1, C); g8::set_B(gi, Bt, Bt, u.pn * 256, u.pn * 256, 16, DM, R0, R1, C); }
    __device__ __forceinline__ g8::EpiScaleBf16<PARTS> epi(const g8::Unit& u) const { return (O2 && u.pn >= 7) ? g8::EpiScaleBf16<PARTS>{O2, PR_LD, PR_LD, rstd, u.pm * 256, (u.pn - 7) * 256} : g8::EpiScaleBf16<PARTS>{O, ld, ncols, rstd, u.pm * 256, u.pn * 256}; }
};
__device__ __forceinline__ void memkv_gemm(Frame& F, int l, int vb);
__device__ __forceinline__ void phase_inproj(Frame& F, int l) {
    bf16_t* WB = WSP(bf16_t, WS_W + (size_t)l * W_STRIDE);
    { ProbInproj<4> pb; pb.S.init(NT / 256, PINP / 256, GRID, F.bid); pb.wave = F.wave; pb.A = (const bf16_t*)((const char*)F.out + DO_XB); pb.Bt = WB + W_IN / 2; pb.O = WSP(bf16_t, WS_PA); pb.O2 = WSP(bf16_t, WS_PR); pb.rstd = WSP(float, WS_SSQ); pb.ld = PA_LD; pb.ncols = PA_LD;
#if DYN_GEMM
      g8::gemm_units_dyn<false>(F.lds, F.wave, F.lane, pb, (unsigned*)(F.ws + WS_CTL + 64 * KiB) + (l * 8 + 0) * 64, NT / 256, PINP / 256); }
#else
      g8::gemm_units<false>(F.lds, F.wave, F.lane, pb); }
#endif
    if (l == 0) { refresh(F); memkv_gemm(F, 0, F.bid); }
}
__device__ __forceinline__ void memkv_gemm(Frame& F, int l, int vb) {
    bf16_t* WB = WSP(bf16_t, WS_W + (size_t)l * W_STRIDE);
    { ProbInproj<1> pb; pb.S.init(NMROWS / 256, 2, GRID, vb); pb.wave = F.wave; pb.A = WSP(bf16_t, WS_MEMB); pb.Bt = WB + W_MEM / 2; pb.O = WSP(bf16_t, WS_MEMKV); pb.O2 = nullptr; pb.rstd = WSP(float, WS_RSTDM); pb.ld = 512; pb.ncols = 512;
      g8::gemm_units<false>(F.lds, F.wave, F.lane, pb); }
}

constexpr int RL_MUP = 0, RL_MUN = 1152, RL_W0 = 2304, RL_A0 = 2816, RL_KK = 3328, RL_KA = 3584, RL_RK = 3840, RL_N = 4096;
struct Sh8Raw { u32x4 c, p, n; };
__device__ __forceinline__ void rw_load8(const char* P, unsigned rowb, int t, int col, Sh8Raw& r) {
    const unsigned off = rowb + (unsigned)col * 2u;
    r.c = *(const u32x4*)(P + off); r.p = *(const u32x4*)(P + (t > 0 ? off - PR_LD * 2 : off)); r.n = *(const u32x4*)(P + (t < SEQ - 1 ? off + PR_LD * 2 : off));
}
__device__ __forceinline__ void rw_shift8(const Sh8Raw& r, int t, int col, const LAS float* cst, float (&o)[8]) {
    const bool hp = t > 0, hn = t < SEQ - 1;
    const u32x4 pz = (u32x4){hp ? r.p.x : 0u, hp ? r.p.y : 0u, hp ? r.p.z : 0u, hp ? r.p.w : 0u}, nz = (u32x4){hn ? r.n.x : 0u, hn ? r.n.y : 0u, hn ? r.n.z : 0u, hn ? r.n.w : 0u};
    float c[8], pr[8], nx[8]; unpack8(r.c, c); unpack8(pz, pr); unpack8(nz, nx);
    const f32x4 m0 = *(const LAS f32x4*)(cst + RL_MUP + col), m1 = *(const LAS f32x4*)(cst + RL_MUP + col + 4), n0 = *(const LAS f32x4*)(cst + RL_MUN + col), n1 = *(const LAS f32x4*)(cst + RL_MUN + col + 4);
#pragma unroll
    for (int e = 0; e < 4; ++e) { o[e] = c[e] + m0[e] * (pr[e] - c[e]) + n0[e] * (nx[e] - c[e]); o[4 + e] = c[4 + e] + m1[e] * (pr[4 + e] - c[4 + e]) + n1[e] * (nx[4 + e] - c[4 + e]); }
}
struct Sh4Raw { u32x2 c, p, n; };
__device__ __forceinline__ void rw_load4(const char* P, unsigned rowb, int t, int col, Sh4Raw& r) {
    const unsigned off = rowb + (unsigned)col * 2u;
    r.c = *(const u32x2*)(P + off); r.p = *(const u32x2*)(P + (t > 0 ? off - PR_LD * 2 : off)); r.n = *(const u32x2*)(P + (t < SEQ - 1 ? off + PR_LD * 2 : off));
}
__device__ __forceinline__ f32x4 rw_shift4(const Sh4Raw& r, int t, int col, const LAS float* cst) {
    const bool hp = t > 0, hn = t < SEQ - 1;
    const u32x2 pv = (u32x2){hp ? r.p.x : 0u, hp ? r.p.y : 0u}, nv = (u32x2){hn ? r.n.x : 0u, hn ? r.n.y : 0u};
    const f32x4 c = (f32x4){bflo(r.c.x), bfhi(r.c.x), bflo(r.c.y), bfhi(r.c.y)}, pr = (f32x4){bflo(pv.x), bfhi(pv.x), bflo(pv.y), bfhi(pv.y)}, nx = (f32x4){bflo(nv.x), bfhi(nv.x), bflo(nv.y), bfhi(nv.y)};
    return c + *(const LAS f32x4*)(cst + RL_MUP + col) * (pr - c) + *(const LAS f32x4*)(cst + RL_MUN + col) * (nx - c);
}
#ifndef RWP_VAR
#define RWP_VAR 0
#endif
__device__ __forceinline__ void st4bf(char* base, unsigned off, const f32x4 v) { u32x2 w; w.x = pk2(v[0], v[1]); w.y = pk2(v[2], v[3]); *(u32x2*)(base + off) = w; }
__device__ __forceinline__ u32x2 pk4(const f32x4 v) { u32x2 w; w.x = pk2(v[0], v[1]); w.y = pk2(v[2], v[3]); return w; }
#define ST4W(base, off, w) do { if (RWP_VAR == 1 && F.dup) { dmy ^= (w).x ^ (w).y; } else *(u32x2*)((base) + (off)) = (w); } while (0)
#define ST4BF(base, off, v) do { if (RWP_VAR == 1 && F.dup) { const f32x4 v_ = (v); dmy ^= pk2(v_[0], v_[1]) ^ pk2(v_[2], v_[3]); } else st4bf(base, off, v); } while (0)

constexpr int KVS = 68;
__device__ __forceinline__ void load_row64(const bf16_t* src, float (&f)[64]) {
    const u32x4* s = (const u32x4*)src;
#pragma unroll
    for (int i = 0; i < 8; ++i) { const u32x4 v = s[i];
        f[i * 8 + 0] = bflo(v.x); f[i * 8 + 1] = bfhi(v.x); f[i * 8 + 2] = bflo(v.y); f[i * 8 + 3] = bfhi(v.y);
        f[i * 8 + 4] = bflo(v.z); f[i * 8 + 5] = bfhi(v.z); f[i * 8 + 6] = bflo(v.w); f[i * 8 + 7] = bfhi(v.w); }
}
__device__ __forceinline__ void norm_row64(float (&f)[64], const float* w, float extra) {
    float ss = 0.f;
#pragma unroll
    for (int d = 0; d < 64; ++d) ss += f[d] * f[d];
    const float rs = rsqrtf(ss * (1.0f / 64.0f) + 1e-6f) * extra;
#pragma unroll
    for (int d = 0; d < 64; ++d) f[d] = f[d] * rs * w[d];
}
typedef __bf16 bf16x2_t __attribute__((ext_vector_type(2)));
__device__ __forceinline__ void pack_row64(const float (&f)[64], unsigned (&p)[32]) {
#pragma unroll
    for (int i = 0; i < 32; ++i) p[i] = pk2(f[2 * i], f[2 * i + 1]);
}
__device__ __forceinline__ void store_row64_lds(LAS bf16_t* dst, const float (&f)[64]) {
#pragma unroll
    for (int i = 0; i < 16; ++i) { u32x2 w; w.x = pk2(f[i * 4], f[i * 4 + 1]); w.y = pk2(f[i * 4 + 2], f[i * 4 + 3]); *(LAS u32x2*)(dst + i * 4) = w; }
}
__device__ __forceinline__ float dot_row64_lds(const LAS bf16_t* krow, const unsigned (&q)[32]) {
    float s0 = 0.f, s1 = 0.f;
#pragma unroll
    for (int i = 0; i < 16; ++i) { const u32x2 w = *(const LAS u32x2*)(krow + i * 4);
        s0 = __builtin_amdgcn_fdot2_f32_bf16(__builtin_bit_cast(bf16x2_t, q[2 * i]), __builtin_bit_cast(bf16x2_t, w.x), s0, false);
        s1 = __builtin_amdgcn_fdot2_f32_bf16(__builtin_bit_cast(bf16x2_t, q[2 * i + 1]), __builtin_bit_cast(bf16x2_t, w.y), s1, false); }
    return s0 + s1;
}

typedef short s16x4 __attribute__((ext_vector_type(4)));
constexpr int VST_PITCH = 144;
__device__ __forceinline__ void norm_frag(const u32x4 r0, const u32x4 r1, const float (&wv)[16], float extra, bf16x8 (&fr)[2]) {
    float f[16]; unpack8(r0, f); unpack8(r1, f + 8);
    float ss = 0.f;
#pragma unroll
    for (int e = 0; e < 16; ++e) ss += f[e] * f[e];
    ss += __shfl_xor(ss, 16); ss += __shfl_xor(ss, 32);
    const float rs = rsqrtf(ss * (1.0f / 64.0f) + 1e-6f) * extra;
#pragma unroll
    for (int e = 0; e < 16; ++e) f[e] = f[e] * rs * wv[e];
    fr[0] = pack8(f); fr[1] = pack8(f + 8);
}
__device__ __forceinline__ void load_norm_frag(const bf16_t* rowp, int g, const float (&wv)[16], float extra, bf16x8 (&fr)[2]) {
    float f[16]; unpack8(*(const u32x4*)(rowp + 8 * g), f); unpack8(*(const u32x4*)(rowp + 32 + 8 * g), f + 8);
    float ss = 0.f;
#pragma unroll
    for (int e = 0; e < 16; ++e) ss += f[e] * f[e];
    ss += __shfl_xor(ss, 16); ss += __shfl_xor(ss, 32);
    const float rs = rsqrtf(ss * (1.0f / 64.0f) + 1e-6f) * extra;
#pragma unroll
    for (int e = 0; e < 16; ++e) f[e] = f[e] * rs * wv[e];
    fr[0] = pack8(f); fr[1] = pack8(f + 8);
}
template <bool NA>
__device__ __forceinline__ void attn_wave_unit(int lane, LAS unsigned char* vst, const bf16_t* qrow0, const float (&wqv)[16], const float (&wkv)[16],
                                               const bf16_t* kbase, size_t nstep, size_t istep, int voff, bf16_t* out0,
                                               const float* rpb_h, int r, int rs, int cb, int q0) {
    const int c16 = lane & 15, g = lane >> 4;
    bf16x8 qf[2]; load_norm_frag(qrow0 + (size_t)c16 * PA_LD, g, wqv, 0.125f, qf);
    float s[16][4];
    const int qc = q0 + c16, cs = min(max(qc - 8, 0), 48);
#pragma unroll
    for (int t = 0; t < 16; ++t) {
        const int n = t >> 1, half = t & 1;
        bf16x8 kf[2]; load_norm_frag(kbase + (size_t)n * nstep + (size_t)(half * 16 + c16) * istep, g, wkv, 1.0f, kf);
        f32x4 acc = (f32x4){0.f, 0.f, 0.f, 0.f};
        acc = __builtin_amdgcn_mfma_f32_16x16x32_bf16(kf[0], qf[0], acc, 0, 0, 0);
        acc = __builtin_amdgcn_mfma_f32_16x16x32_bf16(kf[1], qf[1], acc, 0, 0, 0);
#pragma unroll
        for (int j = 0; j < 4; ++j) {
            if (NA) { const int kc = cb + half * 16 + 4 * g + j; const bool ok = (kc >= cs) && (kc < cs + 16);
                s[t][j] = ok ? acc[j] + rpb_h[(rs + n - r + 7) * 31 + (ok ? kc - qc + 15 : 0)] : -1e30f; }
            else s[t][j] = acc[j];
        }
    }
    float m = -1e30f;
#pragma unroll
    for (int t = 0; t < 16; ++t)
#pragma unroll
        for (int j = 0; j < 4; ++j) m = fmaxf(m, s[t][j]);
    m = fmaxf(m, __shfl_xor(m, 16)); m = fmaxf(m, __shfl_xor(m, 32));
    float ls = 0.f;
#pragma unroll
    for (int t = 0; t < 16; ++t)
#pragma unroll
        for (int j = 0; j < 4; ++j) { const float p = (NA && s[t][j] < -1e29f) ? 0.f : __expf(s[t][j] - m); s[t][j] = p; ls += p; }
    ls += __shfl_xor(ls, 16); ls += __shfl_xor(ls, 32);
    f32x4 o[4];
#pragma unroll
    for (int dt = 0; dt < 4; ++dt) o[dt] = (f32x4){0.f, 0.f, 0.f, 0.f};
    const int q4 = c16 >> 2, p4 = lane & 3;
    const int ki = lane >> 1, hf = lane & 1;
    const bf16_t* vsrc = kbase + voff + (size_t)ki * istep + hf * 32;
    u32x4 v0, v1, v2, v3;
    { const u32x4* src = (const u32x4*)vsrc; v0 = src[0]; v1 = src[1]; v2 = src[2]; v3 = src[3]; }
#pragma unroll
    for (int n = 0; n < 8; ++n) {
        LAS unsigned char* vb = vst + (n & 1) * (32 * VST_PITCH);
        { LAS u32x4* dst = (LAS u32x4*)(vb + ki * VST_PITCH + hf * 64); dst[0] = v0; dst[1] = v1; dst[2] = v2; dst[3] = v3; }
        if (n + 1 < 8) { const u32x4* src = (const u32x4*)(vsrc + (size_t)(n + 1) * nstep); v0 = src[0]; v1 = src[1]; v2 = src[2]; v3 = src[3]; }
        float pf[8] = {s[2 * n][0], s[2 * n][1], s[2 * n][2], s[2 * n][3], s[2 * n + 1][0], s[2 * n + 1][1], s[2 * n + 1][2], s[2 * n + 1][3]};
        const bf16x8 pb = pack8(pf);
#pragma unroll
        for (int dt = 0; dt < 4; ++dt) {
            const s16x4 va = __builtin_amdgcn_ds_read_tr16_b64_v4i16((LAS s16x4*)(vb + (4 * g + q4) * VST_PITCH + 32 * dt + 8 * p4));
            const s16x4 vb2 = __builtin_amdgcn_ds_read_tr16_b64_v4i16((LAS s16x4*)(vb + (16 + 4 * g + q4) * VST_PITCH + 32 * dt + 8 * p4));
            const bf16x8 vt = (bf16x8){va[0], va[1], va[2], va[3], vb2[0], vb2[1], vb2[2], vb2[3]};
            o[dt] = __builtin_amdgcn_mfma_f32_16x16x32_bf16(vt, pb, o[dt], 0, 0, 0);
        }
    }
    const float inv = __builtin_amdgcn_rcpf(ls);
    int l2; asm volatile("v_mbcnt_lo_u32_b32 %0, -1, 0\n\tv_mbcnt_hi_u32_b32 %0, -1, %0" : "=v"(l2));
    bf16_t* op = out0 + (unsigned)((l2 & 15) * DM + 4 * (l2 >> 4));
#pragma unroll
    for (int dt = 0; dt < 4; ++dt) { u32x2 w; w.x = pk2(o[dt][0] * inv, o[dt][1] * inv); w.y = pk2(o[dt][2] * inv, o[dt][3] * inv);
        *(u32x2*)(op + 16 * dt) = w; }
}
__device__ __forceinline__ void mem_wave_unit(int lane, const LAS unsigned char* kimg, const LAS unsigned char* vimg, const bf16_t* qrow0, const float (&wqv)[16], bf16_t* out0) {
    const int c16 = lane & 15, g = lane >> 4;
    bf16x8 qf[2]; load_norm_frag(qrow0 + (size_t)c16 * PA_LD, g, wqv, 0.125f * 1.44269504089f, qf);
    float s[16][4];
#pragma unroll
    for (int t = 0; t < 16; ++t) {
        if ((t & 3) == 0) __builtin_amdgcn_sched_barrier(0);
        const LAS unsigned char* kr = kimg + (16 * t + c16) * VST_PITCH + 16 * g;
        const bf16x8 k0 = *(const LAS bf16x8*)kr, k1 = *(const LAS bf16x8*)(kr + 64);
        f32x4 acc = (f32x4){0.f, 0.f, 0.f, 0.f};
        acc = __builtin_amdgcn_mfma_f32_16x16x32_bf16(k0, qf[0], acc, 0, 0, 0);
        acc = __builtin_amdgcn_mfma_f32_16x16x32_bf16(k1, qf[1], acc, 0, 0, 0);
#pragma unroll
        for (int j = 0; j < 4; ++j) s[t][j] = acc[j];
    }
    float m = -1e30f;
#pragma unroll
    for (int t = 0; t < 16; ++t)
#pragma unroll
        for (int j = 0; j < 4; ++j) m = fmaxf(m, s[t][j]);
    m = fmaxf(m, __shfl_xor(m, 16)); m = fmaxf(m, __shfl_xor(m, 32));
    float ls = 0.f;
#pragma unroll
    for (int t = 0; t < 16; ++t)
#pragma unroll
        for (int j = 0; j < 4; ++j) { const float p = __builtin_amdgcn_exp2f(s[t][j] - m); s[t][j] = p; ls += p; }
    ls += __shfl_xor(ls, 16); ls += __shfl_xor(ls, 32);
    f32x4 o[4];
#pragma unroll
    for (int dt = 0; dt < 4; ++dt) o[dt] = (f32x4){0.f, 0.f, 0.f, 0.f};
    const int q4 = c16 >> 2, p4 = lane & 3;
#pragma unroll
    for (int n = 0; n < 8; ++n) {
        float pf[8] = {s[2 * n][0], s[2 * n][1], s[2 * n][2], s[2 * n][3], s[2 * n + 1][0], s[2 * n + 1][1], s[2 * n + 1][2], s[2 * n + 1][3]};
        const bf16x8 pb = pack8(pf);
        const LAS unsigned char* vb = vimg + (32 * n) * VST_PITCH;
#pragma unroll
        for (int dt = 0; dt < 4; ++dt) {
            const s16x4 va = __builtin_amdgcn_ds_read_tr16_b64_v4i16((LAS s16x4*)(vb + (4 * g + q4) * VST_PITCH + 32 * dt + 8 * p4));
            const s16x4 vb2 = __builtin_amdgcn_ds_read_tr16_b64_v4i16((LAS s16x4*)(vb + (16 + 4 * g + q4) * VST_PITCH + 32 * dt + 8 * p4));
            const bf16x8 vt = (bf16x8){va[0], va[1], va[2], va[3], vb2[0], vb2[1], vb2[2], vb2[3]};
            o[dt] = __builtin_amdgcn_mfma_f32_16x16x32_bf16(vt, pb, o[dt], 0, 0, 0);
        }
    }
    const float inv = __builtin_amdgcn_rcpf(ls);
    int l2; asm volatile("v_mbcnt_lo_u32_b32 %0, -1, 0\n\tv_mbcnt_hi_u32_b32 %0, -1, %0" : "=v"(l2));
    bf16_t* op = out0 + (unsigned)((l2 & 15) * DM + 4 * (l2 >> 4));
#pragma unroll
    for (int dt = 0; dt < 4; ++dt) { u32x2 w; w.x = pk2(o[dt][0] * inv, o[dt][1] * inv); w.y = pk2(o[dt][2] * inv, o[dt][3] * inv);
        *(u32x2*)(op + 16 * dt) = w; }
}
constexpr int NA_ROWB = 64 * 128, NA_RING = 9 * NA_ROWB;
__device__ __forceinline__ void na_wave_unit(int lane, const LAS unsigned char* kring, const LAS unsigned char* vring, const bf16x8 (&qf)[2], u32x2 (&ow)[4],
                                             const LAS float* rpb_h, int r, int rs, int cb, int q0) {
    const int c16 = lane & 15, g = lane >> 4;
    float s[16][4];
    const int qc = q0 + c16, cs = min(max(qc - 8, 0), 48);
    const int slot0 = rs % 9;
#define NA_BIAS(dst, t_) do { _Pragma("unroll") for (int j_ = 0; j_ < 4; ++j_) dst[j_] = rpb_h[(rs + ((t_) >> 1) - r + 7) * 31 + min(max(cb + ((t_) & 1) * 16 + 4 * g + j_ - qc + 15, 0), 30)]; } while (0)
    float bv[4]; NA_BIAS(bv, 0);
#pragma unroll
    for (int t = 0; t < 16; ++t) {
        if ((t & 3) == 0) __builtin_amdgcn_sched_barrier(0);
        const int n = t >> 1, half = t & 1;
        const int slot = slot0 + n >= 9 ? slot0 + n - 9 : slot0 + n;
        const int key = cb + half * 16 + c16, sw = key & 7;
        const LAS unsigned char* kr = kring + slot * NA_ROWB + key * 128;
        const bf16x8 k0 = *(const LAS bf16x8*)(kr + ((g ^ sw) << 4)), k1 = *(const LAS bf16x8*)(kr + (((4 + g) ^ sw) << 4));
        float bn[4] = {0.f, 0.f, 0.f, 0.f}; if (t < 15) NA_BIAS(bn, t + 1);
        asm volatile("" : "+v"(bv[0]), "+v"(bv[1]), "+v"(bv[2]), "+v"(bv[3]));
        f32x4 acc = (f32x4){bv[0], bv[1], bv[2], bv[3]};
        acc = __builtin_amdgcn_mfma_f32_16x16x32_bf16(k0, qf[0], acc, 0, 0, 0);
        acc = __builtin_amdgcn_mfma_f32_16x16x32_bf16(k1, qf[1], acc, 0, 0, 0);
#pragma unroll
        for (int j = 0; j < 4; ++j) { const int kc = cb + half * 16 + 4 * g + j; const bool ok = (kc >= cs) && (kc < cs + 16);
            s[t][j] = ok ? acc[j] : -1e30f; }
#pragma unroll
        for (int j = 0; j < 4; ++j) bv[j] = bn[j];
    }
#undef NA_BIAS
    float m = -1e30f;
#pragma unroll
    for (int t = 0; t < 16; ++t)
#pragma unroll
        for (int j = 0; j < 4; ++j) m = fmaxf(m, s[t][j]);
    m = fmaxf(m, __shfl_xor(m, 16)); m = fmaxf(m, __shfl_xor(m, 32));
    float ls = 0.f;
#pragma unroll
    for (int t = 0; t < 16; ++t)
#pragma unroll
        for (int j = 0; j < 4; ++j) { const float p = __builtin_amdgcn_exp2f(s[t][j] - m); s[t][j] = p; ls += p; }
    ls += __shfl_xor(ls, 16); ls += __shfl_xor(ls, 32);
    f32x4 o[4];
#pragma unroll
    for (int dt = 0; dt < 4; ++dt) o[dt] = (f32x4){0.f, 0.f, 0.f, 0.f};
    const int q4 = c16 >> 2, p4 = lane & 3;
    const int keyA = cb + 4 * g + q4, keyB = keyA + 16;
#pragma unroll
    for (int n = 0; n < 8; ++n) {
        const int slot = slot0 + n >= 9 ? slot0 + n - 9 : slot0 + n;
        float pf[8] = {s[2 * n][0], s[2 * n][1], s[2 * n][2], s[2 * n][3], s[2 * n + 1][0], s[2 * n + 1][1], s[2 * n + 1][2], s[2 * n + 1][3]};
        const bf16x8 pb = pack8(pf);
        const LAS unsigned char* va0 = vring + slot * NA_ROWB + keyA * 128 + 8 * (p4 & 1); const LAS unsigned char* vb0 = vring + slot * NA_ROWB + keyB * 128 + 8 * (p4 & 1);
#pragma unroll
        for (int dt = 0; dt < 4; ++dt) {
            const s16x4 va = __builtin_amdgcn_ds_read_tr16_b64_v4i16((LAS s16x4*)(va0 + (((2 * dt + (p4 >> 1)) ^ (keyA & 7)) << 4)));
            const s16x4 vb2 = __builtin_amdgcn_ds_read_tr16_b64_v4i16((LAS s16x4*)(vb0 + (((2 * dt + (p4 >> 1)) ^ (keyB & 7)) << 4)));
            const bf16x8 vt = (bf16x8){va[0], va[1], va[2], va[3], vb2[0], vb2[1], vb2[2], vb2[3]};
            o[dt] = __builtin_amdgcn_mfma_f32_16x16x32_bf16(vt, pb, o[dt], 0, 0, 0);
        }
    }
    const float inv = __builtin_amdgcn_rcpf(ls);
#pragma unroll
    for (int dt = 0; dt < 4; ++dt) { ow[dt].x = pk2(o[dt][0] * inv, o[dt][1] * inv); ow[dt].y = pk2(o[dt][2] * inv, o[dt][3] * inv); }
}
__device__ __forceinline__ void na_load_rows(int tid, LAS unsigned char* kring, LAS unsigned char* vring, const bf16_t* P, int b, int h, int row_first, int nrows, const float* wk) {
    for (int w = tid; w < nrows * 128; w += NTHREADS) {
        const int row = row_first + (w >> 7), kind = (w >> 6) & 1, key = w & 63, slot = row % 9, sw = key & 7;
        const u32x4* src = (const u32x4*)(P + ((size_t)b * SEQ + row * 64 + key) * PA_LD + (kind ? C_V : C_K) + h * 64);
        LAS unsigned char* dst = (kind ? vring : kring) + slot * NA_ROWB + key * 128;
        u32x4 v[8];
#pragma unroll
        for (int c = 0; c < 8; ++c) v[c] = src[c];
        if (kind == 0) {
            float f[64];
#pragma unroll
            for (int c = 0; c < 8; ++c) unpack8(v[c], f + 8 * c);
            float ss = 0.f;
#pragma unroll
            for (int e = 0; e < 64; ++e) ss += f[e] * f[e];
            const float rs = rsqrtf(ss * (1.0f / 64.0f) + 1e-6f);
#pragma unroll
            for (int e = 0; e < 64; ++e) f[e] = f[e] * rs * wk[e];
#pragma unroll
            for (int c = 0; c < 8; ++c) *(LAS bf16x8*)(dst + ((c ^ sw) << 4)) = pack8(f + 8 * c);
        } else {
#pragma unroll
            for (int c = 0; c < 8; ++c) *(LAS u32x4*)(dst + ((c ^ sw) << 4)) = v[c];
        }
    }
}
__device__ __forceinline__ void load_wv(const float* w, int g, float (&wv)[16]) {
#pragma unroll
    for (int e = 0; e < 8; ++e) { wv[e] = w[8 * g + e]; wv[8 + e] = w[32 + 8 * g + e]; }
}
#if !BRUTE_ATTN
__device__ __forceinline__ void mem_unit(Frame& F, int l, int u) {
    const bf16_t* P = WSP(bf16_t, WS_PA); bf16_t* MIX = (bf16_t*)F.out; const bf16_t* MKV = WSP(bf16_t, WS_MEMKV);
    const int g = F.lane >> 4;
    LAS unsigned char* kimg = F.lds; LAS unsigned char* vimg = F.lds + 256 * VST_PITCH;
    float wqv[16]; load_wv(F.in[21] + l * 64, g, wqv);
    const float* wk = F.in[22] + l * 64;
    const int part = u & 7, h = (u >> 3) & 3, b = u >> 5;
    {   const int key = F.tid >> 1, hf = F.tid & 1;
        const bf16_t* src = MKV + ((size_t)b * NMEM + key) * 512 + h * 64 + hf * 32;
        float f[32]; unpack8(*(const u32x4*)src, f); unpack8(*(const u32x4*)(src + 8), f + 8); unpack8(*(const u32x4*)(src + 16), f + 16); unpack8(*(const u32x4*)(src + 24), f + 24);
        float ss = 0.f;
#pragma unroll
        for (int e = 0; e < 32; ++e) ss += f[e] * f[e];
        ss += __shfl_xor(ss, 1);
        const float rs = rsqrtf(ss * (1.0f / 64.0f) + 1e-6f);
#pragma unroll
        for (int e = 0; e < 32; ++e) f[e] = f[e] * rs * wk[hf * 32 + e];
        LAS bf16x8* kd = (LAS bf16x8*)(kimg + key * VST_PITCH + hf * 64);
        kd[0] = pack8(f); kd[1] = pack8(f + 8); kd[2] = pack8(f + 16); kd[3] = pack8(f + 24);
        const u32x4* vs = (const u32x4*)(src + 256); LAS u32x4* vd = (LAS u32x4*)(vimg + key * VST_PITCH + hf * 64);
        vd[0] = vs[0]; vd[1] = vs[1]; vd[2] = vs[2]; vd[3] = vs[3]; }
    __syncthreads();
    for (int i = 0; i < 8; ++i) {
        const int qblk = part * 64 + F.wave * 8 + i; const size_t tok0 = (size_t)b * SEQ + qblk * 16;
        mem_wave_unit(F.lane, kimg, vimg, P + tok0 * PA_LD + C_MQ + h * 64, wqv, MIX + tok0 * DM + 768 + h * 64);
    }
}
constexpr int NA_STEPS = 8, NA_UPH = 64 / NA_STEPS;
__device__ __forceinline__ void na_unit(Frame& F, int l, int u) {
    const bf16_t* P = WSP(bf16_t, WS_PA); bf16_t* MIX = (bf16_t*)F.out;
    const int g = F.lane >> 4, c16 = F.lane & 15;
    LAS unsigned char* kring = F.lds; LAS unsigned char* vring = F.lds + NA_RING;
    LAS float* rpbl = (LAS float*)(F.lds + LDS_RPB);
    float wqv[16]; load_wv(F.in[4] + l * 64, g, wqv);
    const float* wk = F.in[5] + l * 64;
    const int rq = u % NA_UPH, h = (u / NA_UPH) & 7, b = u / (NA_UPH * 8), qb = F.wave & 3;
    const int cb = qb == 0 ? 0 : (qb == 1 ? 8 : (qb == 2 ? 24 : 32));
    { const float* rpb = F.in[6] + ((size_t)l * 8 + h) * 15 * 31; if (F.tid < 465) rpbl[F.tid] = rpb[F.tid] * 1.44269504089f; if (F.tid < 64) rpbl[480 + F.tid] = wk[F.tid]; }
    const int n_rs = F.tid >> 8, n_kind = (F.tid >> 7) & 1, n_key = (F.tid >> 1) & 63, n_half = F.tid & 1;
    const int ra0 = rq * (2 * NA_STEPS);
    const bf16_t* qp = P + ((size_t)b * SEQ + (ra0 + (F.wave >> 2)) * 64 + qb * 16 + c16) * PA_LD + h * 64 + 8 * g;
    int loaded_hi;
    { const int lo = min(max(ra0 - 4, 0), 120), hi = min(max(ra0 + 1 - 4, 0), 120) + 7; na_load_rows(F.tid, kring, vring, P, b, h, lo, hi - lo + 1, wk); loaded_hi = hi; }
    bf16x8 qf[2]; { const u32x4 qr0 = *(const u32x4*)qp, qr1 = *(const u32x4*)(qp + 32); norm_frag(qr0, qr1, wqv, 0.125f * 1.44269504089f, qf); }
    __syncthreads();
    for (int i = 0; i < NA_STEPS; ++i) {
        const int ra = ra0 + 2 * i;
        u32x4 pv[4] = {}, nq0 = {}, nq1 = {}; int n_row = -1;
        if (i + 1 < NA_STEPS) {
            const int hi2 = min(max(ra + 3 - 4, 0), 120) + 7;
            if (loaded_hi + 1 + n_rs <= hi2) n_row = loaded_hi + 1 + n_rs;
            loaded_hi = hi2;
            const u32x4* src = (const u32x4*)(P + ((size_t)b * SEQ + (n_row < 0 ? 0 : n_row) * 64 + n_key) * PA_LD + (n_kind ? C_V : C_K) + h * 64 + n_half * 32);
            if (n_row >= 0) { pv[0] = src[0]; pv[1] = src[1]; pv[2] = src[2]; pv[3] = src[3]; }
            const bf16_t* qn = qp + (size_t)(2 * (i + 1)) * 64 * PA_LD; nq0 = *(const u32x4*)qn; nq1 = *(const u32x4*)(qn + 32);
        }
        const int r = ra + (F.wave >> 2), rs = min(max(r - 4, 0), 120);
        const size_t tok0 = (size_t)b * SEQ + r * 64 + qb * 16;
        u32x2 ow[4];
        na_wave_unit(F.lane, kring, vring, qf, ow, rpbl, r, rs, cb, qb * 16);
        if (i + 1 < NA_STEPS) {
            __syncthreads();
            float f[32];
#pragma unroll
            for (int c = 0; c < 4; ++c) unpack8(pv[c], f + 8 * c);
            float ss = 0.f;
#pragma unroll
            for (int e = 0; e < 32; ++e) ss += f[e] * f[e];
            ss += __shfl_xor(ss, 1);
            const float rsn = rsqrtf(ss * (1.0f / 64.0f) + 1e-6f);
            if (n_row >= 0) {
                LAS unsigned char* dst = (n_kind ? vring : kring) + (n_row % 9) * NA_ROWB + n_key * 128; const int sw = n_key & 7;
                if (n_kind == 0) {
#pragma unroll
                    for (int c = 0; c < 4; ++c) { const f32x4 w0 = *(const LAS f32x4*)(rpbl + 480 + n_half * 32 + 8 * c), w1 = *(const LAS f32x4*)(rpbl + 480 + n_half * 32 + 8 * c + 4);
#pragma unroll
                        for (int e = 0; e < 4; ++e) { f[8 * c + e] *= rsn * w0[e]; f[8 * c + 4 + e] *= rsn * w1[e]; }
                        *(LAS bf16x8*)(dst + (((n_half * 4 + c) ^ sw) << 4)) = pack8(f + 8 * c); }
                } else {
#pragma unroll
                    for (int c = 0; c < 4; ++c) *(LAS u32x4*)(dst + (((n_half * 4 + c) ^ sw) << 4)) = pv[c];
                }
            }
            norm_frag(nq0, nq1, wqv, 0.125f * 1.44269504089f, qf);
        }
        { int l2; asm volatile("v_mbcnt_lo_u32_b32 %0, -1, 0\n\tv_mbcnt_hi_u32_b32 %0, -1, %0" : "=v"(l2));
          bf16_t* op = MIX + tok0 * DM + h * 64 + (unsigned)((l2 & 15) * DM + 4 * (l2 >> 4));
#pragma unroll
          for (int dt = 0; dt < 4; ++dt) *(u32x2*)(op + 16 * dt) = ow[dt]; }
        if (i + 1 < NA_STEPS) __syncthreads();
    }
}
#endif
#if BRUTE_ATTN
__device__ __forceinline__ void phase_attn(Frame& F, int l) {
    const bf16_t* P = WSP(bf16_t, WS_PA); bf16_t* MIX = (bf16_t*)F.out; const bf16_t* MKV = WSP(bf16_t, WS_MEMKV);
    const int h = F.tid >> 6, d = F.tid & 63;
    for (int tok = F.bid; tok < NT; tok += GRID) {
        const int b = tok >> 13, sidx = tok & (SEQ - 1), r = sidx >> 6, c = sidx & 63;
        {   const float* wq = F.in[4] + l * 64; const float* wk = F.in[5] + l * 64; const float* rpb = F.in[6] + (size_t)l * 8 * 15 * 31;
            float q[64]; float ss = 0.f;
#pragma unroll
            for (int i = 0; i < 64; ++i) { q[i] = bf2f(P[(size_t)tok * PIN + h * 64 + i]); ss += q[i] * q[i]; }
            { const float rs = 1.0f / sqrtf(ss / 64.0f + 1e-6f);
#pragma unroll
              for (int i = 0; i < 64; ++i) q[i] = q[i] * rs * wq[i] * wk[i]; }
            const int rs0 = min(max(r - 4, 0), 120), cs0 = min(max(c - 8, 0), 48);
            float mx = -1e30f, den = 0.f, o = 0.f;
#pragma unroll 1
            for (int pass = 0; pass < 2; ++pass)
#pragma unroll 1
                for (int nm = 0; nm < 128; ++nm) { const int n = nm >> 4, m = nm & 15;
                    const size_t kt = (size_t)b * SEQ + (rs0 + n) * 64 + cs0 + m; const bf16_t* kp = P + kt * PIN + C_K + h * 64;
                    float ks = 0.f, dt = 0.f;
#pragma unroll
                    for (int i8 = 0; i8 < 8; ++i8) { const u32x4 kv4 = ((const u32x4*)kp)[i8]; const unsigned kw[4] = {kv4.x, kv4.y, kv4.z, kv4.w};
#pragma unroll
                        for (int e = 0; e < 4; ++e) { const float k0 = bflo(kw[e]), k1 = bfhi(kw[e]); ks += k0 * k0 + k1 * k1; dt += q[i8 * 8 + 2 * e] * k0 + q[i8 * 8 + 2 * e + 1] * k1; } }
                    const float s = dt / sqrtf(ks / 64.0f + 1e-6f) * 0.125f + rpb[((size_t)h * 15 + (rs0 + n - r + 7)) * 31 + (cs0 + m - c + 15)];
                    if (pass == 0) mx = fmaxf(mx, s); else { const float p = expf(s - mx); den += p; o += p * bf2f(P[kt * PIN + C_V + h * 64 + d]); }
                }
            MIX[(size_t)tok * DM + h * 64 + d] = f2bf(o / den);
        }
    }
    __syncthreads();
    for (int tok = F.bid; tok < NT; tok += GRID) {
        const int b = tok >> 13;
        if (F.tid < 256) {
            const float* wq = F.in[21] + l * 64; const float* wk = F.in[22] + l * 64;
            float q[64]; float ss = 0.f;
#pragma unroll
            for (int i = 0; i < 64; ++i) { q[i] = bf2f(P[(size_t)tok * PIN + C_MQ + h * 64 + i]); ss += q[i] * q[i]; }
            { const float rs = 1.0f / sqrtf(ss / 64.0f + 1e-6f);
#pragma unroll
              for (int i = 0; i < 64; ++i) q[i] = q[i] * rs * wq[i] * wk[i]; }
            float mx = -1e30f, den = 0.f, o = 0.f;
#pragma unroll 1
            for (int pass = 0; pass < 2; ++pass)
#pragma unroll 1
                for (int m = 0; m < NMEM; ++m) {
                    const bf16_t* kp = MKV + ((size_t)b * NMEM + m) * 512 + h * 64;
                    float ks = 0.f, dt = 0.f;
#pragma unroll
                    for (int i8 = 0; i8 < 8; ++i8) { const u32x4 kv4 = ((const u32x4*)kp)[i8]; const unsigned kw[4] = {kv4.x, kv4.y, kv4.z, kv4.w};
#pragma unroll
                        for (int e = 0; e < 4; ++e) { const float k0 = bflo(kw[e]), k1 = bfhi(kw[e]); ks += k0 * k0 + k1 * k1; dt += q[i8 * 8 + 2 * e] * k0 + q[i8 * 8 + 2 * e + 1] * k1; } }
                    const float s = dt / sqrtf(ks / 64.0f + 1e-6f) * 0.125f;
                    if (pass == 0) mx = fmaxf(mx, s); else { const float p = expf(s - mx); den += p; o += p * bf2f(kp[256 + d]); }
                }
            MIX[(size_t)tok * DM + 768 + h * 64 + d] = f2bf(o / den);
        }
    }
}
#endif

#if NAIVE_SCAN
__device__ __forceinline__ void phase_scan(Frame& F, int l) {
    if (F.wave != 0 || F.bid >= 64) return;
    const int id = F.bid, b = id >> 3, h = (id >> 1) & 3, dir = id & 1, lane = F.lane;
    LAS float* L = (LAS float*)F.lds;
    const bf16_t* Rb = RWBUF(0); const bf16_t* Kb = RWBUF(1); const bf16_t* KKb = RWBUF(2); const bf16_t* Vb = RWBUF(3);
    const bf16_t* Eb = RWBUF(4 + dir); const bf16_t* Ab = RWBUF(6 + dir);
    bf16_t* Y = (bf16_t*)(F.ws + WS_Y + (size_t)dir * RWB);
    const float ka = F.in[15][l * 256 + h * 64 + lane];
    const size_t base = (size_t)b * SEQ * 256 + h * 64 + lane;
    float S[64];
#pragma unroll
    for (int k = 0; k < 64; ++k) S[k] = 0.f;
    size_t o = base + (size_t)(dir ? SEQ - 1 : 0) * 256;
    bf16_t nr = Rb[o], nk = Kb[o], nkk = KKb[o], nv = Vb[o], ne = Eb[o], na = Ab[o];
    for (int step = 0; step < SEQ; ++step) {
        const int t = dir ? SEQ - 1 - step : step;
        const float r = bf2f(nr), k = bf2f(nk), kk = bf2f(nkk), v = bf2f(nv), e = bf2f(ne), a = bf2f(na);
        if (step + 1 < SEQ) { o = base + (size_t)(dir ? t - 1 : t + 1) * 256; nr = Rb[o]; nk = Kb[o]; nkk = KKb[o]; nv = Vb[o]; ne = Eb[o]; na = Ab[o]; }
        const float w = __expf(-e), kd = k * (1.0f + (a - 1.0f) * ka), bt = kk * a;
        asm volatile("" ::: "memory");
        L[lane] = w; L[64 + lane] = kk; L[128 + lane] = bt; L[192 + lane] = kd; L[256 + lane] = r;
        asm volatile("s_waitcnt lgkmcnt(0)" ::: "memory");
        float s0 = 0.f, s1 = 0.f, s2 = 0.f, s3 = 0.f;
#pragma unroll
        for (int k4 = 0; k4 < 16; ++k4) { const f32x4 x = *(const LAS f32x4*)(L + 64 + k4 * 4); s0 += S[k4 * 4] * x[0]; s1 += S[k4 * 4 + 1] * x[1]; s2 += S[k4 * 4 + 2] * x[2]; s3 += S[k4 * 4 + 3] * x[3]; }
        const float sa = -((s0 + s1) + (s2 + s3));
        float y0 = 0.f, y1 = 0.f, y2 = 0.f, y3 = 0.f;
#pragma unroll
        for (int k4 = 0; k4 < 16; ++k4) {
            const f32x4 w4 = *(const LAS f32x4*)(L + k4 * 4), b4 = *(const LAS f32x4*)(L + 128 + k4 * 4), d4 = *(const LAS f32x4*)(L + 192 + k4 * 4), r4 = *(const LAS f32x4*)(L + 256 + k4 * 4);
            S[k4 * 4] = S[k4 * 4] * w4[0] + sa * b4[0] + v * d4[0]; y0 += S[k4 * 4] * r4[0];
            S[k4 * 4 + 1] = S[k4 * 4 + 1] * w4[1] + sa * b4[1] + v * d4[1]; y1 += S[k4 * 4 + 1] * r4[1];
            S[k4 * 4 + 2] = S[k4 * 4 + 2] * w4[2] + sa * b4[2] + v * d4[2]; y2 += S[k4 * 4 + 2] * r4[2];
            S[k4 * 4 + 3] = S[k4 * 4 + 3] * w4[3] + sa * b4[3] + v * d4[3]; y3 += S[k4 * 4 + 3] * r4[3];
        }
        Y[base + (size_t)t * 256] = f2bf((y0 + y1) + (y2 + y3));
        asm volatile("" ::: "memory");
    }
}

#else
typedef short s16x4 __attribute__((ext_vector_type(4)));
constexpr int CHSZ = 10240;
constexpr int CH_AT = 0, CH_R = 2048, CH_F8 = 4096, CH_GAM = 9728;
constexpr int IMG_PITCH = 144, WL_AH = 0, WL_BT = 2304, WL_KT = 4608, WL_T = 6912, WL_MKA = 7424, WL_MBAT = 7936, WL_BYTES = 8960;
#define DPP_SHR(x, n) __builtin_bit_cast(float, __builtin_amdgcn_update_dpp(0, __builtin_bit_cast(int, (x)), 0x110 + (n), 0xf, 0xf, true))
__device__ __forceinline__ f32x4 mfma16x2(const s16x4 a0, const s16x4 b0, const s16x4 a1, const s16x4 b1, const f32x4 c) {
    const bf16x8 a8 = (bf16x8){a0[0], a0[1], a0[2], a0[3], a1[0], a1[1], a1[2], a1[3]}, b8 = (bf16x8){b0[0], b0[1], b0[2], b0[3], b1[0], b1[1], b1[2], b1[3]};
    return __builtin_amdgcn_mfma_f32_16x16x32_bf16(a8, b8, c, 0, 0, 0);
}
__device__ __forceinline__ f32x4 mfma16pad(const s16x4 a, const s16x4 bq, const f32x4 c, int, int, int) {
    const bf16x8 a8 = (bf16x8){a[0], a[1], a[2], a[3], 0, 0, 0, 0}, b8 = (bf16x8){bq[0], bq[1], bq[2], bq[3], 0, 0, 0, 0};
    return __builtin_amdgcn_mfma_f32_16x16x32_bf16(a8, b8, c, 0, 0, 0);
}
__device__ __forceinline__ s16x4 pack4(const f32x4 v) { u32x2 w; w.x = pk2(v[0], v[1]); w.y = pk2(v[2], v[3]); return __builtin_bit_cast(s16x4, w); }
__device__ __forceinline__ bf16x8 pack44(const f32x4 a, const f32x4 b) { u32x4 w; w.x = pk2(a[0], a[1]); w.y = pk2(a[2], a[3]); w.z = pk2(b[0], b[1]); w.w = pk2(b[2], b[3]); return __builtin_bit_cast(bf16x8, w); }
__device__ __forceinline__ void load16(const bf16_t* p, int g, float (&f)[16]) {
#pragma unroll
    for (int q = 0; q < 4; ++q) { const u32x2 v = *(const u32x2*)(p + 16 * q + 4 * g); f[4 * q] = bflo(v.x); f[4 * q + 1] = bfhi(v.x); f[4 * q + 2] = bflo(v.y); f[4 * q + 3] = bfhi(v.y); }
}
__device__ __forceinline__ void store_img(LAS unsigned char* img, int step, int g, const float (&f)[16]) {
#pragma unroll
    for (int q = 0; q < 4; ++q) { u32x2 w; w.x = pk2(f[4 * q], f[4 * q + 1]); w.y = pk2(f[4 * q + 2], f[4 * q + 3]); *(LAS u32x2*)(img + step * IMG_PITCH + (16 * q + 4 * g) * 2) = w; }
}
struct ChunkRaw { u32x2 r[4], k[4], kk[4], e[4], a[4]; };
__device__ __forceinline__ void chunk_fetch(ChunkRaw& c, const bf16_t* Rb, const bf16_t* Kb, const bf16_t* KKb, const bf16_t* Eb, const bf16_t* Ab, size_t rowo  , int g) {
#pragma unroll
    for (int q = 0; q < 4; ++q) { const size_t o = rowo + 16 * q + 4 * g; c.r[q] = *(const u32x2*)(Rb + o); c.k[q] = *(const u32x2*)(Kb + o); c.kk[q] = *(const u32x2*)(KKb + o); c.e[q] = *(const u32x2*)(Eb + o); c.a[q] = *(const u32x2*)(Ab + o); }
}
__device__ __forceinline__ void unpack16(const u32x2 (&v)[4], float (&f)[16]) {
#pragma unroll
    for (int q = 0; q < 4; ++q) { f[4 * q] = bflo(v[q].x); f[4 * q + 1] = bfhi(v[q].x); f[4 * q + 2] = bflo(v[q].y); f[4 * q + 3] = bfhi(v[q].y); }
}
__device__ __forceinline__ void rwkv_chunk_unit(int lane, LAS unsigned char* wl, const ChunkRaw& raw, const float (&kav)[16], unsigned char* ch) {
    const int st = lane & 15, g = lane >> 4, q4 = st >> 2, p4 = lane & 3;
    float r[16], k[16], kk[16], e[16], a[16];
    unpack16(raw.r, r); unpack16(raw.k, k); unpack16(raw.kk, kk); unpack16(raw.e, e); unpack16(raw.a, a);
    float Ah[16], Bh[16], Kh[16], Rh[16], Bt[16], Kt[16];
#pragma unroll
    for (int x = 0; x < 16; ++x) {
        float E = e[x]; E += DPP_SHR(E, 1); E += DPP_SHR(E, 2); E += DPP_SHR(E, 4); E += DPP_SHR(E, 8);
        const float EC = __shfl(E, (lane & 48) | 15);
        const float xm = __expf(e[x] - E), xp = __expf(E), xn = __expf(-E), xt = __expf(E - EC);
        const float be = kk[x] * a[x], kd = k[x] * (1.0f + (a[x] - 1.0f) * kav[x]);
        Ah[x] = -kk[x] * xm; Bh[x] = be * xp; Kh[x] = kd * xp; Rh[x] = r[x] * xn; Bt[x] = be * xt; Kt[x] = kd * xt;
        e[x] = __expf(-EC);
    }
    store_img(wl + WL_AH, st, g, Ah); store_img(wl + WL_BT, st, g, Bt); store_img(wl + WL_KT, st, g, Kt);
    if (st == 15) {
#pragma unroll
        for (int q = 0; q < 4; ++q) *(f32x4*)(ch + CH_GAM + (16 * q + 4 * g) * 4) = (f32x4){e[4 * q], e[4 * q + 1], e[4 * q + 2], e[4 * q + 3]};
    }
    bf16x8 AhF[2], BhF[2], KhF[2], RhF[2];
#pragma unroll
    for (int s = 0; s < 2; ++s) { AhF[s] = pack8(Ah + 8 * s); BhF[s] = pack8(Bh + 8 * s); KhF[s] = pack8(Kh + 8 * s); RhF[s] = pack8(Rh + 8 * s); }
    const f32x4 z4 = (f32x4){0.f, 0.f, 0.f, 0.f};
    f32x4 p1 = __builtin_amdgcn_mfma_f32_16x16x32_bf16(BhF[0], AhF[0], z4, 0, 0, 0); p1 = __builtin_amdgcn_mfma_f32_16x16x32_bf16(BhF[1], AhF[1], p1, 0, 0, 0);
    f32x4 p2 = __builtin_amdgcn_mfma_f32_16x16x32_bf16(AhF[0], KhF[0], z4, 0, 0, 0); p2 = __builtin_amdgcn_mfma_f32_16x16x32_bf16(AhF[1], KhF[1], p2, 0, 0, 0);
    f32x4 p3 = __builtin_amdgcn_mfma_f32_16x16x32_bf16(BhF[0], RhF[0], z4, 0, 0, 0); p3 = __builtin_amdgcn_mfma_f32_16x16x32_bf16(BhF[1], RhF[1], p3, 0, 0, 0);
    f32x4 pr4 = __builtin_amdgcn_mfma_f32_16x16x32_bf16(KhF[0], RhF[0], z4, 0, 0, 0); pr4 = __builtin_amdgcn_mfma_f32_16x16x32_bf16(KhF[1], RhF[1], pr4, 0, 0, 0);
#pragma unroll
    for (int jj = 0; jj < 4; ++jj) { const int row = 4 * g + jj;
        p1[jj] = row < st ? p1[jj] : 0.f;
        p2[jj] = st < row ? p2[jj] : 0.f;
        p3[jj] = row <= st ? p3[jj] : 0.f;
        pr4[jj] = row <= st ? pr4[jj] : 0.f; }
    *(LAS f32x4*)(wl + WL_MBAT + (st * 16 + 4 * g) * 4) = p1;
    *(LAS s16x4*)(wl + WL_MKA + (st * 16 + 4 * g) * 2) = pack4(p2);
    *(s16x4*)(ch + CH_F8 + 1 * 512 + lane * 8) = pack4(p3);
    *(s16x4*)(ch + CH_F8 + 2 * 512 + lane * 8) = pack4(pr4);
    float x[16];
#pragma unroll
    for (int i = 0; i < 16; ++i) {
        float acc = (st == i) ? 1.0f : 0.0f;
#pragma unroll
        for (int j4 = 0; j4 < (i + 3) / 4; ++j4) { const f32x4 mm = *(const LAS f32x4*)(wl + WL_MBAT + (i * 16 + 4 * j4) * 4);
#pragma unroll
            for (int jj = 0; jj < 4; ++jj) if (4 * j4 + jj < i) acc += x[4 * j4 + jj] * mm[jj]; }
        x[i] = acc;
    }
    if (g == 0) { *(LAS bf16x8*)(wl + WL_T + st * 32) = pack8(x); *(LAS bf16x8*)(wl + WL_T + st * 32 + 16) = pack8(x + 8); }
    const s16x4 tB = __builtin_amdgcn_ds_read_tr16_b64_v4i16((LAS s16x4*)(wl + WL_T + (4 * g + q4) * 32 + 8 * p4));
    f32x4 at[4];
#pragma unroll
    for (int t = 0; t < 4; ++t) { const s16x4 aA = __builtin_amdgcn_ds_read_tr16_b64_v4i16((LAS s16x4*)(wl + WL_AH + (4 * g + q4) * IMG_PITCH + 32 * t + 8 * p4));
        at[t] = mfma16pad(aA, tB, z4, 0, 0, 0); }
    *(bf16x8*)(ch + CH_AT + lane * 16) = pack44(at[0], at[1]); *(bf16x8*)(ch + CH_AT + 1024 + lane * 16) = pack44(at[2], at[3]);
    { const s16x4 mA = *(const LAS s16x4*)(wl + WL_MKA + (st * 16 + 4 * g) * 2);
      const f32x4 mt = mfma16pad(mA, tB, z4, 0, 0, 0);
      *(s16x4*)(ch + CH_F8 + 0 * 512 + lane * 8) = pack4(mt); }
    *(bf16x8*)(ch + CH_R + lane * 16) = RhF[0]; *(bf16x8*)(ch + CH_R + 1024 + lane * 16) = RhF[1];
#pragma unroll
    for (int t = 0; t < 4; ++t) {
        *(s16x4*)(ch + CH_F8 + (3 + t) * 512 + lane * 8) = __builtin_amdgcn_ds_read_tr16_b64_v4i16((LAS s16x4*)(wl + WL_BT + (4 * g + q4) * IMG_PITCH + 32 * t + 8 * p4));
        *(s16x4*)(ch + CH_F8 + (7 + t) * 512 + lane * 8) = __builtin_amdgcn_ds_read_tr16_b64_v4i16((LAS s16x4*)(wl + WL_KT + (4 * g + q4) * IMG_PITCH + 32 * t + 8 * p4));
    }
}
#define RWP_BAR() do { asm volatile("" ::: "memory"); __builtin_amdgcn_s_barrier(); asm volatile("" ::: "memory"); } while (0)
constexpr int RWP_SLOT = 7 * 4 * 512;
__device__ __forceinline__ void phase_rwprep(Frame& F, int l) {
    const char* P = (const char*)WSP(bf16_t, WS_PR);
    LAS float* cst = (LAS float*)F.lds;
    const int pw_ = F.wave & 3;
    LAS unsigned char* slot = F.lds + RL_N * 4 + pw_ * RWP_SLOT;
    LAS unsigned char* wl = F.lds + RL_N * 4 + 4 * RWP_SLOT + pw_ * WL_BYTES;
    unsigned char* CH = F.ws + WS_CH;
    {   const float* mup = F.in[7] + l * 1152; const float* mun = F.in[8] + l * 1152; const float* w0 = F.in[9] + l * 512; const float* a0 = F.in[11] + l * 512;
        const float* k_k = F.in[14] + l * 256; const float* k_a = F.in[15] + l * 256; const float* r_k = F.in[16] + l * 256;
        for (int i = F.tid; i < 1152; i += NTHREADS) { cst[RL_MUP + i] = mup[i]; cst[RL_MUN + i] = mun[i]; }
        { const int i = F.tid; cst[RL_W0 + i] = w0[i]; cst[RL_A0 + i] = a0[i]; if (i < 256) { cst[RL_KK + i] = k_k[i]; cst[RL_KA + i] = k_a[i]; cst[RL_RK + i] = r_k[i]; } }
        __syncthreads(); }
    const char* W2T = (const char*)WSP(bf16_t, WS_LORA + (size_t)l * LORA_STRIDE); const char* A2T = W2T + 2 * 256 * 64 * 2; const char* G2T = A2T + 2 * 256 * 64 * 2;
    if (F.wave >= 4) {
        for (int un = F.bid * 4 + pw_; un < NT / 16; un += GRID * 4) {
#pragma unroll 1
            for (int hh_ = 0; hh_ < 4; ++hh_) {
                int hh = hh_; asm volatile("" : "+v"(hh)); hh = __builtin_amdgcn_readfirstlane(hh);
                RWP_BAR();
                RWP_BAR();
                int lane; asm volatile("v_mbcnt_lo_u32_b32 %0, -1, 0\n\tv_mbcnt_hi_u32_b32 %0, -1, %0" : "=v"(lane));
                const int g = lane >> 4, cb_ = un >> 9, cc_ = un & 511;
                float kav[16];
#pragma unroll
                for (int q = 0; q < 4; ++q) { const f32x4 v4 = *(const LAS f32x4*)(cst + RL_KA + hh * 64 + 16 * q + 4 * g); kav[4 * q] = v4[0]; kav[4 * q + 1] = v4[1]; kav[4 * q + 2] = v4[2]; kav[4 * q + 3] = v4[3]; }
#pragma unroll 1
                for (int dir_ = 0; dir_ < 2; ++dir_) {
                    int dir = dir_; asm volatile("" : "+v"(dir)); dir = __builtin_amdgcn_readfirstlane(dir);
                    const int ls = dir ? ((lane & 48) | (15 - (lane & 15))) : lane;
                    const LAS unsigned char* sp = slot + ls * 8;
                    ChunkRaw cr;
#pragma unroll
                    for (int q = 0; q < 4; ++q) { cr.r[q] = *(const LAS u32x2*)(sp + (0 * 4 + q) * 512); cr.k[q] = *(const LAS u32x2*)(sp + (1 * 4 + q) * 512); cr.kk[q] = *(const LAS u32x2*)(sp + (2 * 4 + q) * 512);
                        cr.e[q] = *(const LAS u32x2*)(sp + ((3 + dir) * 4 + q) * 512); cr.a[q] = *(const LAS u32x2*)(sp + ((5 + dir) * 4 + q) * 512); }
                    rwkv_chunk_unit(lane, wl, cr, kav, CH + ((size_t)((cb_ * 4 + hh) * 2 + dir) * 512 + (dir ? 511 - cc_ : cc_)) * CHSZ);
                }
            }
        }
        return;
    }
    for (int un = F.bid * 4 + pw_; un < NT / 16; un += GRID * 4) {
        int lane; asm volatile("v_mbcnt_lo_u32_b32 %0, -1, 0\n\tv_mbcnt_hi_u32_b32 %0, -1, %0" : "=v"(lane));
        const int c16 = lane & 15, g = lane >> 4;
        const unsigned lo64 = (unsigned)(c16 * 64 + 8 * g) * 2u, lo128 = (unsigned)(c16 * 128 + 8 * g) * 2u;
        const unsigned tok = (unsigned)un * 16u + (unsigned)c16; const int t = (int)(tok & (SEQ - 1));
        const unsigned rowb = tok * (unsigned)(PR_LD * 2);
        bf16x8 fwf[2], fwb[2], faf[2], fab[2], fg[4];
        {   Sh8Raw rw[4]; float o[8];
#pragma unroll
            for (int s = 0; s < 2; ++s) { rw_load8(P, rowb, t, 768 + 32 * s + 8 * g, rw[s]); rw_load8(P, rowb, t, 832 + 32 * s + 8 * g, rw[2 + s]); }
#pragma unroll
            for (int s = 0; s < 2; ++s) {
                rw_shift8(rw[s], t, 768 + 32 * s + 8 * g, cst, o);
#pragma unroll
                for (int e = 0; e < 8; ++e) o[e] = 1.0f - 2.0f * __builtin_amdgcn_rcpf(1.0f + __expf(2.0f * o[e]));
                fwf[s] = pack8(o);
                rw_shift8(rw[2 + s], t, 832 + 32 * s + 8 * g, cst, o);
#pragma unroll
                for (int e = 0; e < 8; ++e) o[e] = 1.0f - 2.0f * __builtin_amdgcn_rcpf(1.0f + __expf(2.0f * o[e]));
                fwb[s] = pack8(o); }
            __builtin_amdgcn_sched_barrier(0);
#pragma unroll
            for (int s = 0; s < 2; ++s) { rw_load8(P, rowb, t, 896 + 32 * s + 8 * g, rw[s]); rw_load8(P, rowb, t, 960 + 32 * s + 8 * g, rw[2 + s]); }
#pragma unroll
            for (int s = 0; s < 2; ++s) { rw_shift8(rw[s], t, 896 + 32 * s + 8 * g, cst, o); faf[s] = pack8(o); rw_shift8(rw[2 + s], t, 960 + 32 * s + 8 * g, cst, o); fab[s] = pack8(o); }
            __builtin_amdgcn_sched_barrier(0);
#pragma unroll
            for (int s = 0; s < 4; ++s) rw_load8(P, rowb, t, 1024 + 32 * s + 8 * g, rw[s]);
#pragma unroll
            for (int s = 0; s < 4; ++s) { rw_shift8(rw[s], t, 1024 + 32 * s + 8 * g, cst, o);
#pragma unroll
                for (int e = 0; e < 8; ++e) o[e] = sigmoidf_(o[e]);
                fg[s] = pack8(o); }
            __builtin_amdgcn_sched_barrier(0);
        }
        const unsigned ob = tok * 512u;
#pragma unroll 1
        for (int hh_ = 0; hh_ < 4; ++hh_) {
            int hh = hh_; asm volatile("" : "+v"(hh)); hh = __builtin_amdgcn_readfirstlane(hh);
            f32x4 kxs[4], vs[4]; float ssq = 0.f, bsum = 0.f; u32x2 pw[4][8];
#pragma unroll
            for (int ct4 = 0; ct4 < 4; ++ct4) {
                __builtin_amdgcn_sched_barrier(0);
                const int c0 = hh * 64 + ct4 * 16;
                const int cb = c0 + 4 * g;
                const char* w2f = W2T + (size_t)c0 * 128; const char* w2b = W2T + (size_t)(256 + c0) * 128; const char* a2f = A2T + (size_t)c0 * 128; const char* a2b = A2T + (size_t)(256 + c0) * 128;
                const char* g2p = G2T + (size_t)c0 * 256;
                bf16x8 wA[12]; Sh4Raw rr, rk, rv;
#pragma unroll
                for (int s = 0; s < 2; ++s) { wA[4 * s] = *(const bf16x8*)(w2f + (lo64 + 64 * s)); wA[4 * s + 1] = *(const bf16x8*)(w2b + (lo64 + 64 * s)); wA[4 * s + 2] = *(const bf16x8*)(a2f + (lo64 + 64 * s)); wA[4 * s + 3] = *(const bf16x8*)(a2b + (lo64 + 64 * s)); }
#pragma unroll
                for (int s = 0; s < 4; ++s) wA[8 + s] = *(const bf16x8*)(g2p + (lo128 + 64 * s));
                rw_load4(P, rowb, t, cb, rr); rw_load4(P, rowb, t, 256 + cb, rk); rw_load4(P, rowb, t, 512 + cb, rv);
                const f32x4 z4 = (f32x4){0.f, 0.f, 0.f, 0.f};
                f32x4 awf = z4, awb = z4, aaf = z4, aab = z4, ag = z4;
#pragma unroll
                for (int s = 0; s < 2; ++s) {
                    awf = __builtin_amdgcn_mfma_f32_16x16x32_bf16(wA[4 * s], fwf[s], awf, 0, 0, 0);
                    awb = __builtin_amdgcn_mfma_f32_16x16x32_bf16(wA[4 * s + 1], fwb[s], awb, 0, 0, 0);
                    aaf = __builtin_amdgcn_mfma_f32_16x16x32_bf16(wA[4 * s + 2], faf[s], aaf, 0, 0, 0);
                    aab = __builtin_amdgcn_mfma_f32_16x16x32_bf16(wA[4 * s + 3], fab[s], aab, 0, 0, 0); }
#pragma unroll
                for (int s = 0; s < 4; ++s) ag = __builtin_amdgcn_mfma_f32_16x16x32_bf16(wA[8 + s], fg[s], ag, 0, 0, 0);
                const f32x4 r = rw_shift4(rr, t, cb, cst), k = rw_shift4(rk, t, 256 + cb, cst), v = rw_shift4(rv, t, 512 + cb, cst);
                const f32x4 w0f = *(const LAS f32x4*)(cst + RL_W0 + cb), w0b = *(const LAS f32x4*)(cst + RL_W0 + 256 + cb), a0f = *(const LAS f32x4*)(cst + RL_A0 + cb), a0b = *(const LAS f32x4*)(cst + RL_A0 + 256 + cb);
                const f32x4 kkc = *(const LAS f32x4*)(cst + RL_KK + cb), kac = *(const LAS f32x4*)(cst + RL_KA + cb), rkc = *(const LAS f32x4*)(cst + RL_RK + cb);
                f32x4 ef, eb, af, ab;
#pragma unroll
                for (int j = 0; j < 4; ++j) {
                    ef[j] = 0.60653065971f * sigmoidf_(w0f[j] + awf[j]);
                    eb[j] = 0.60653065971f * sigmoidf_(w0b[j] + awb[j]);
                    af[j] = sigmoidf_(a0f[j] + aaf[j]); ab[j] = sigmoidf_(a0b[j] + aab[j]); }
                const f32x4 kx = k * kkc;
                const f32x4 kdsum = k * (2.0f + (af + ab - 2.0f) * kac);
                const f32x4 bq = r * kdsum * rkc;
                ssq += (kx[0] * kx[0] + kx[1] * kx[1]) + (kx[2] * kx[2] + kx[3] * kx[3]); bsum += (bq[0] + bq[1]) + (bq[2] + bq[3]);
                kxs[ct4] = kx; vs[ct4] = v;
                pw[ct4][0] = pk4(r); pw[ct4][1] = pk4(k); pw[ct4][2] = pk4(v); pw[ct4][3] = pk4(ef); pw[ct4][4] = pk4(eb); pw[ct4][5] = pk4(af); pw[ct4][6] = pk4(ab); pw[ct4][7] = pk4(ag);
            }
            ssq += __shfl_xor(ssq, 16); ssq += __shfl_xor(ssq, 32); bsum += __shfl_xor(bsum, 16); bsum += __shfl_xor(bsum, 32);
            const float rn = 1.0f / fmaxf(sqrtf(ssq), 1e-12f);
#pragma unroll
            for (int ct4 = 0; ct4 < 4; ++ct4) { const unsigned oo = ob + (unsigned)(hh * 64 + ct4 * 16 + 4 * g) * 2u;
                *(u32x2*)((char*)RWBUF(3) + oo) = pw[ct4][2]; *(u32x2*)((char*)RWBUF(8) + oo) = pw[ct4][7]; *(u32x2*)((char*)RWBUF(9) + oo) = pk4(vs[ct4] * bsum); }
            RWP_BAR();
            { LAS unsigned char* sp = slot + lane * 8;
#pragma unroll
              for (int ct4 = 0; ct4 < 4; ++ct4) {
                  *(LAS u32x2*)(sp + (0 * 4 + ct4) * 512) = pw[ct4][0]; *(LAS u32x2*)(sp + (1 * 4 + ct4) * 512) = pw[ct4][1]; *(LAS u32x2*)(sp + (2 * 4 + ct4) * 512) = pk4(kxs[ct4] * rn);
                  *(LAS u32x2*)(sp + (3 * 4 + ct4) * 512) = pw[ct4][3]; *(LAS u32x2*)(sp + (4 * 4 + ct4) * 512) = pw[ct4][4]; *(LAS u32x2*)(sp + (5 * 4 + ct4) * 512) = pw[ct4][5]; *(LAS u32x2*)(sp + (6 * 4 + ct4) * 512) = pw[ct4][6]; } }
            asm volatile("s_waitcnt lgkmcnt(0)" ::: "memory");
            RWP_BAR();
        }
    }
}
#undef RWP_BAR
#define SCAN_BAR() do { asm volatile("" ::: "memory"); __builtin_amdgcn_s_barrier(); asm volatile("" ::: "memory"); } while (0)
constexpr int SCAN_D = 8, SCAN_R = 9, SLOTB = CHSZ + 2048;
__device__ __forceinline__ void scan_issue(__amdgpu_buffer_rsrc_t rsC, __amdgpu_buffer_rsrc_t rsV, LAS unsigned char* ring, int slot, int chunk, int p0, int lane, int dir, unsigned vlane) {
#pragma unroll
    for (int p = 0; p < 3; ++p) {
        const int pc = p0 + p;
        LAS unsigned* dst = (LAS unsigned*)(ring + slot * SLOTB + pc * 1024);
        if (pc < 10) __builtin_amdgcn_raw_ptr_buffer_load_lds(rsC, dst, 16, (unsigned)lane * 16u, (unsigned)chunk * (unsigned)CHSZ + (unsigned)pc * 1024u, 0, 0);
        else { const int tau = 16 * chunk + (pc - 10) * 8 + (lane >> 3), t = dir ? SEQ - 1 - tau : tau;
            __builtin_amdgcn_raw_ptr_buffer_load_lds(rsV, dst, 16, (unsigned)t * 512u + vlane, 0u, 0, 0); }
    }
}
__device__ __forceinline__ void scan_loader(__amdgpu_buffer_rsrc_t rsC, __amdgpu_buffer_rsrc_t rsV, LAS unsigned char* ring, int p0, int lane, int dir, unsigned vlane) {
    for (int cc = 0; cc < SCAN_D; ++cc) scan_issue(rsC, rsV, ring, cc, cc, p0, lane, dir, vlane);
    asm volatile("s_waitcnt vmcnt(18)" ::: "memory");
    SCAN_BAR();
    int slot = SCAN_D % SCAN_R;
    for (int c = 0; c < 512; ++c) {
        const int cn = c + SCAN_D < 512 ? c + SCAN_D : 511;
        scan_issue(rsC, rsV, ring, slot, cn, p0, lane, dir, vlane);
        slot = slot + 1 == SCAN_R ? 0 : slot + 1;
        asm volatile("s_waitcnt vmcnt(18)" ::: "memory");
        SCAN_BAR();
    }
    asm volatile("s_waitcnt vmcnt(0)" ::: "memory");
}
__device__ __forceinline__ void scan_block(Frame& F, int l) {
    const int scan = F.bid, b = scan >> 3, h = (scan >> 1) & 3, dir = scan & 1, lane = F.lane, g = lane >> 4;
    LAS unsigned char* ring = F.lds;
    if (F.wave >= 4) {
        const __amdgpu_buffer_rsrc_t rsC = G8_RSRC(F.ws + WS_CH + (size_t)scan * 512 * CHSZ);
        const __amdgpu_buffer_rsrc_t rsV = G8_RSRC(RWBUF(3) + (size_t)b * SEQ * 256);
        if (SCAN_VAR == 2 && F.dup) { SCAN_BAR(); for (int c = 0; c < 512; ++c) SCAN_BAR(); return; }
        scan_loader(rsC, rsV, ring, (F.wave - 4) * 3, lane, dir, (unsigned)(h * 128 + (lane & 7) * 16));
        return;
    }
    const int vcol = F.wave * 16 + (lane & 15), q4 = (lane & 15) >> 2, p4 = lane & 3;
    bf16_t* Yrow = (bf16_t*)(F.ws + WS_Y + (size_t)dir * RWB) + (size_t)b * SEQ * 256 + h * 64 + F.wave * 16 + (lane & 1) * 8;
    constexpr int YT_PITCH = 48;
    LAS unsigned char* ytile = F.lds + 112 * 1024 + F.wave * (16 * YT_PITCH);
    f32x4 S[4];
#pragma unroll
    for (int t = 0; t < 4; ++t) S[t] = (f32x4){0.f, 0.f, 0.f, 0.f};
    SCAN_BAR();
    struct Ops { bf16x8 AT0, AT1, R0, R1; s16x4 MT, MBR, MKR, Vb, Bt[4], Kt[4]; f32x4 gam[4]; };
    const int vtr = (4 * g + q4) * 128 + (16 * F.wave + 4 * p4) * 2;
#define SCAN_LOAD(o, ch) do { (o).AT0 = *(const LAS bf16x8*)((ch) + CH_AT + lane * 16); (o).AT1 = *(const LAS bf16x8*)((ch) + CH_AT + 1024 + lane * 16); \
        (o).R0 = *(const LAS bf16x8*)((ch) + CH_R + lane * 16); (o).R1 = *(const LAS bf16x8*)((ch) + CH_R + 1024 + lane * 16); \
        (o).MT = *(const LAS s16x4*)((ch) + CH_F8 + lane * 8); (o).MBR = *(const LAS s16x4*)((ch) + CH_F8 + 512 + lane * 8); (o).MKR = *(const LAS s16x4*)((ch) + CH_F8 + 1024 + lane * 8); \
        (o).Vb = __builtin_amdgcn_ds_read_tr16_b64_v4i16((LAS s16x4*)((ch) + CHSZ + vtr)); \
        _Pragma("unroll") for (int t_ = 0; t_ < 4; ++t_) { (o).Bt[t_] = *(const LAS s16x4*)((ch) + CH_F8 + (3 + t_) * 512 + lane * 8); (o).Kt[t_] = *(const LAS s16x4*)((ch) + CH_F8 + (7 + t_) * 512 + lane * 8); \
            (o).gam[t_] = *(const LAS f32x4*)((ch) + CH_GAM + (16 * t_ + 4 * g) * 4); } } while (0)
#define SCAN_STEP(CUR, NXT, c) do { \
        u32x4 yprev = *(const LAS u32x4*)(ytile + ((lane >> 1) & 15) * YT_PITCH + (lane & 1) * 16);          \
        { const LAS unsigned char* chn = ring + slot * SLOTB; SCAN_LOAD(NXT, chn); } \
        slot = slot + 1 == SCAN_R ? 0 : slot + 1; \
        const bf16x8 Sb0 = pack44(S[0], S[1]), Sb1 = pack44(S[2], S[3]); \
        const f32x4 z4 = (f32x4){0.f, 0.f, 0.f, 0.f}; \
        f32x4 y = z4; \
        if (!(SCAN_VAR == 3 && F.dup)) { \
            f32x4 u = __builtin_amdgcn_mfma_f32_16x16x32_bf16((CUR).AT0, Sb0, z4, 0, 0, 0); \
            u = __builtin_amdgcn_mfma_f32_16x16x32_bf16((CUR).AT1, Sb1, u, 0, 0, 0); \
            u = mfma16pad((CUR).MT, (CUR).Vb, u, 0, 0, 0); \
            const s16x4 Ub = pack4(u); \
            asm volatile("" : "+v"(yprev));                     \
            y = __builtin_amdgcn_mfma_f32_16x16x32_bf16((CUR).R0, Sb0, z4, 0, 0, 0); \
            y = __builtin_amdgcn_mfma_f32_16x16x32_bf16((CUR).R1, Sb1, y, 0, 0, 0); \
            y = mfma16x2((CUR).MKR, (CUR).Vb, (CUR).MBR, Ub, y); \
            _Pragma("unroll") for (int t = 0; t < 4; ++t) { S[t] = S[t] * (CUR).gam[t]; S[t] = mfma16x2((CUR).Kt[t], (CUR).Vb, (CUR).Bt[t], Ub, S[t]); } \
        } \
        if ((c) && !(SCAN_VAR >= 1 && F.dup) && lane < 32) { const int tau = 16 * ((c) - 1) + (lane >> 1), t = dir ? SEQ - 1 - tau : tau; *(u32x4*)(Yrow + (size_t)t * 256) = yprev; } \
        if (!(SCAN_VAR >= 1 && F.dup)) {                        \
            _Pragma("unroll") for (int jj = 0; jj < 4; ++jj) *(LAS bf16_t*)(ytile + (4 * g + jj) * YT_PITCH + (lane & 15) * 2) = f2bf(y[jj]); } \
        asm volatile("s_waitcnt lgkmcnt(0)" ::: "memory");        \
        SCAN_BAR(); } while (0)
    Ops opA, opB; SCAN_LOAD(opA, ring);
    int slot = 1;
    for (int c = 0; c < 512; c += 2) { SCAN_STEP(opA, opB, c); SCAN_STEP(opB, opA, c + 1); }
#undef SCAN_STEP
    if (!(SCAN_VAR >= 1 && F.dup) && lane < 32) { const int tau = 16 * 511 + (lane >> 1), t = dir ? SEQ - 1 - tau : tau; *(u32x4*)(Yrow + (size_t)t * 256) = *(const LAS u32x4*)(ytile + (lane >> 1) * YT_PITCH + (lane & 1) * 16); }
#undef SCAN_LOAD
}
constexpr int WP_UNITS = 768;
__device__ __forceinline__ void phase_scanmix(Frame& F, int l) {
    if (F.bid < 64 && !(SCAN_VAR == 4 && F.dup)) scan_block(F, l);
    unsigned* ctr = (unsigned*)(F.ws + WS_CTL + 512 * KiB) + l * 64 + ((SCAN_VAR == 4 && F.dup) ? 32 : 0);
    volatile LAS int* qs = (volatile LAS int*)(F.lds + LDS_MISC + 64);
    const int n_na = NB * 8 * NA_UPH, n_mem = NB * 4 * 8, total = n_na + n_mem + (l == 0 ? WP_UNITS : 0);
    for (;;) {
        refresh(F);
        __syncthreads();
        if (F.tid == 0) *qs = (int)__hip_atomic_fetch_add(ctr, 1u, __ATOMIC_RELAXED, __HIP_MEMORY_SCOPE_AGENT);
        __syncthreads();
        const int u = __builtin_amdgcn_readfirstlane(*qs);
        if (u >= total) break;
        if (u < n_na) na_unit(F, l, u);
        else if (u < n_na + n_mem) mem_unit(F, l, u - n_na);
        else weight_prep(F, 1, F.bid - (u - n_na - n_mem), WP_UNITS);
    }
}

#endif
__device__ __forceinline__ void phase_rwpost(Frame& F, int l) {
    const bf16_t* Yf = (const bf16_t*)(F.ws + WS_Y); const bf16_t* Yb = (const bf16_t*)(F.ws + WS_Y + RWB);
    const bf16_t* Gb = RWBUF(8); const bf16_t* Bn = RWBUF(9);
    bf16_t* MIX = (bf16_t*)F.out;
    const float* lnw = F.in[17] + l * 256; const float* lnb = F.in[18] + l * 256;
    const int pair = F.lane >> 3, sub = F.lane & 7, h = pair & 3, c = h * 64 + sub * 8;
    float lw[8], lb[8];
#pragma unroll
    for (int e = 0; e < 8; ++e) { lw[e] = lnw[c + e]; lb[e] = lnb[c + e]; }
    u32x4 r0, r1, r2, r3;
    { const size_t idx = (size_t)((F.bid * NWAVES + F.wave) * 2 + (pair >> 2)) * 256 + c; r0 = *(const u32x4*)(Yf + idx); r1 = *(const u32x4*)(Yb + idx); r2 = *(const u32x4*)(Gb + idx); r3 = *(const u32x4*)(Bn + idx); }
    for (int wu = F.bid * NWAVES + F.wave; wu < NT / 2; wu += GRID * NWAVES) {
        const int tok = wu * 2 + (pair >> 2);
        float yf[8], yb[8], gg[8], bn[8];
        unpack8(r0, yf); unpack8(r1, yb); unpack8(r2, gg); unpack8(r3, bn);
        { const int wn = wu + GRID * NWAVES < NT / 2 ? wu + GRID * NWAVES : wu; const size_t idx = (size_t)(wn * 2 + (pair >> 2)) * 256 + c;
          r0 = *(const u32x4*)(Yf + idx); r1 = *(const u32x4*)(Yb + idx); r2 = *(const u32x4*)(Gb + idx); r3 = *(const u32x4*)(Bn + idx); }
        float s = 0.f;
#pragma unroll
        for (int e = 0; e < 8; ++e) { yf[e] += yb[e]; s += yf[e]; }
        s += __shfl_xor(s, 1); s += __shfl_xor(s, 2); s += __shfl_xor(s, 4);
        const float mu = s * (1.0f / 64.0f); float q = 0.f;
#pragma unroll
        for (int e = 0; e < 8; ++e) { yf[e] -= mu; q += yf[e] * yf[e]; }
        q += __shfl_xor(q, 1); q += __shfl_xor(q, 2); q += __shfl_xor(q, 4);
        const float rs = rsqrtf(q * (1.0f / 64.0f) + 64e-5f);
#pragma unroll
        for (int e = 0; e < 8; ++e) yf[e] = (yf[e] * rs * lw[e] + lb[e] + bn[e]) * gg[e];
        *(bf16x8*)(MIX + (size_t)tok * DM + 512 + c) = pack8(yf);
    }
}

struct ProbOutproj {
    g8::StaticOrder S; int wave; const bf16_t* A; const bf16_t* Bt; const bf16_t* xres; bf16_t* xb2; float* ssq;
    __device__ __forceinline__ bool next(int i, g8::Unit& u) const { return S.next(i, u); }
    __device__ __forceinline__ void setup(const g8::Unit& u, g8::GemmIn& gi) const { int R0, R1, C; g8::stage_coords_now(wave, R0, R1, C); g8::set_A_rows(gi, A, u.pm * 256, DM, R0, R1, C); g8::set_B(gi, Bt, Bt, u.pn * 256, u.pn * 256, 16, DM, R0, R1, C); }
    __device__ __forceinline__ g8::EpiResid epi(const g8::Unit& u) const { return g8::EpiResid{xres, nullptr, xb2, nullptr, ssq, u.pm * 256, u.pn * 256}; }
};
__device__ __forceinline__ void phase_outproj(Frame& F, int l) {
    bf16_t* WB = WSP(bf16_t, WS_W + (size_t)l * W_STRIDE);
    ProbOutproj pb; pb.wave = F.wave; pb.S.init(NT / 256, DM / 256, GRID, F.bid);
    pb.A = (const bf16_t*)F.out; pb.Bt = WB + W_OUT / 2; pb.xres = (const bf16_t*)((const char*)F.out + DO_XB); pb.xb2 = WSP(bf16_t, WS_XB2); pb.ssq = WSP(float, WS_SSQ2);
    g8::gemm_units<false>(F.lds, F.wave, F.lane, pb);
}

__device__ __forceinline__ void phase_router(Frame& F, int l) {
    LAS unsigned char* WRB = F.lds;
    LAS float* BIAS = (LAS float*)(F.lds + 131072);
    LAS int* HI = (LAS int*)(F.lds + 131072 + 128);
    LAS float* LG = (LAS float*)(F.lds + 131072 + 256) + F.wave * (16 * 33);
    const int lane = F.lane;
    { const u32x4* src = (const u32x4*)(F.ws + WS_WR2 + (size_t)l * WR_STRIDE);
#pragma unroll
        for (int i = 0; i < 16; ++i) *(LAS u32x4*)(WRB + (i * NTHREADS + F.tid) * 16) = src[i * NTHREADS + F.tid];
        if (F.tid < 8) *(LAS u32x4*)(WRB + 131072 + F.tid * 16) = src[8192 + F.tid]; }
    int* cls = WSP(int, WS_CLS); float* wlo = WSP(float, WS_WLO); float* whi = WSP(float, WS_WHI); float* rstd2 = WSP(float, WS_RSTD2); int* hist = WSP(int, WS_HIST);
    const bf16_t* X = WSP(bf16_t, WS_XB2); const float* ssq = WSP(float, WS_SSQ2);
    for (int tt = F.bid; tt < NT / 256; tt += GRID) {
        if (F.tid < 32) HI[F.tid] = 0;
        __syncthreads();
        for (int i = 0; i < 2; ++i) {
            const int tok0 = tt * 256 + (F.wave * 2 + i) * 16;
            const bf16_t* xp = X + (size_t)(tok0 + (lane & 15)) * DM + 8 * (lane >> 4);
            bf16x8 a[32];
#pragma unroll
            for (int ks = 0; ks < 32; ++ks) a[ks] = *(const bf16x8*)(xp + ks * 32);
            f32x4 c0 = {0.f, 0.f, 0.f, 0.f}, c1 = {0.f, 0.f, 0.f, 0.f}, e0 = {0.f, 0.f, 0.f, 0.f}, e1 = {0.f, 0.f, 0.f, 0.f};
#pragma unroll
            for (int ks = 0; ks < 32; ++ks) {
                const bf16x8 b0 = *(const LAS bf16x8*)(WRB + (ks * 64 + lane) * 16), b1 = *(const LAS bf16x8*)(WRB + ((32 + ks) * 64 + lane) * 16);
                const bf16x8 d0 = *(const LAS bf16x8*)(WRB + 65536 + (ks * 64 + lane) * 16), d1 = *(const LAS bf16x8*)(WRB + 65536 + ((32 + ks) * 64 + lane) * 16);
                c0 = __builtin_amdgcn_mfma_f32_16x16x32_bf16(a[ks], b0, c0, 0, 0, 0); c1 = __builtin_amdgcn_mfma_f32_16x16x32_bf16(a[ks], b1, c1, 0, 0, 0);
                e0 = __builtin_amdgcn_mfma_f32_16x16x32_bf16(a[ks], d0, e0, 0, 0, 0); e1 = __builtin_amdgcn_mfma_f32_16x16x32_bf16(a[ks], d1, e1, 0, 0, 0); }
            c0 += e0; c1 += e1;
#pragma unroll
            for (int r = 0; r < 4; ++r) { LG[(4 * (lane >> 4) + r) * 33 + (lane & 15)] = c0[r]; LG[(4 * (lane >> 4) + r) * 33 + 16 + (lane & 15)] = c1[r]; }
            const int tok = tok0 + (lane & 15);
            const float ss = (ssq[tok] + ssq[(size_t)NT + tok]) + (ssq[(size_t)2 * NT + tok] + ssq[(size_t)3 * NT + tok]);
            const float rs = rsqrtf(ss * (1.0f / DM) + 1e-6f);
            float lg[20];
#pragma unroll
            for (int o = 0; o < 20; ++o) lg[o] = LG[(lane & 15) * 33 + o] * rs + BIAS[o];
            int g = 0; float gm = lg[0];
#pragma unroll
            for (int o = 1; o < 4; ++o) if (lg[o] > gm) { gm = lg[o]; g = o; }
            float gs = 0.f;
#pragma unroll
            for (int o = 0; o < 4; ++o) gs += __expf(lg[o] - gm);
            const float gw = __builtin_amdgcn_rcpf(gs);
            float sel[4];
#pragma unroll
            for (int o = 0; o < 4; ++o) sel[o] = g == 0 ? lg[4 + o] : (g == 1 ? lg[8 + o] : (g == 2 ? lg[12 + o] : lg[16 + o]));
            int i1 = 0; float m1 = sel[0];
#pragma unroll
            for (int o = 1; o < 4; ++o) if (sel[o] > m1) { m1 = sel[o]; i1 = o; }
            int i2 = -1; float m2 = -3.0e38f;
#pragma unroll
            for (int o = 0; o < 4; ++o) if (o != i1 && sel[o] > m2) { m2 = sel[o]; i2 = o; }
            const float p1 = __builtin_amdgcn_rcpf(1.0f + __expf(m2 - m1)), p2 = 1.0f - p1;
            const int lo = i1 < i2 ? i1 : i2, hi = i1 < i2 ? i2 : i1;
            const float wl_ = gw * (i1 < i2 ? p1 : p2), wh_ = gw * (i1 < i2 ? p2 : p1);
            const int pair = lo == 0 ? hi - 1 : (lo == 1 ? hi + 1 : 5);
            const int c = g * 6 + pair;
            if (lane < 16) { cls[tok] = c; wlo[tok] = wl_; whi[tok] = wh_; rstd2[tok] = rs; atomicAdd((int*)&HI[c], 1); }
        }
        __syncthreads();
        if (F.tid < 32) hist[tt * 32 + F.tid] = HI[F.tid];
        __syncthreads();
    }
}

__device__ __forceinline__ void phase_scatter(Frame& F, int l) {
    LAS int* TOT = (LAS int*)F.lds;
    LAS int* BEF = TOT + 32;
    LAS int* RST = TOT + 64;
    LAS int* CL = TOT + 128;
    const int* cls = WSP(int, WS_CLS); const int* hist = WSP(int, WS_HIST);
    int* tokpos = WSP(int, WS_TOKPOS); float* wlos = WSP(float, WS_WLOS); float* whis = WSP(float, WS_WHIS); float* rstds = WSP(float, WS_RSTDS); int* tilecls = WSP(int, WS_TILECLS);
    for (int tt = F.bid; tt < NT / 256; tt += GRID) {
        if (F.tid < 24) { int tot = 0, bef = 0; for (int t2 = 0; t2 < NT / 256; ++t2) { const int hv = hist[t2 * 32 + F.tid]; tot += hv; bef += (t2 < tt) ? hv : 0; } TOT[F.tid] = tot; BEF[F.tid] = bef; }
        if (F.tid < 256) CL[F.tid] = cls[tt * 256 + F.tid];
        __syncthreads();
        if (F.tid == 0) { int acc = 0; for (int c = 0; c < 24; ++c) { RST[c] = acc; acc += ((TOT[c] + 255) >> 8) << 8; } RST[24] = acc; }
        __syncthreads();
        if (F.tid < 256) {
            const int tok = tt * 256 + F.tid, c = CL[F.tid]; int rank = 0;
            for (int j = 0; j < F.tid; ++j) rank += (CL[j] == c) ? 1 : 0;
            const int pos = RST[c] + BEF[c] + rank;
            tokpos[pos] = tok; wlos[pos] = WSP(float, WS_WLO)[tok]; whis[pos] = WSP(float, WS_WHI)[tok]; rstds[pos] = WSP(float, WS_RSTD2)[tok];
        }
        if (tt == 0) {
            for (int c = 0; c < 24; ++c) {
                const int pend = RST[c + 1], p0 = RST[c] + TOT[c];
                for (int p = p0 + F.tid; p < pend; p += NTHREADS) { tokpos[p] = -1; wlos[p] = 0.f; whis[p] = 0.f; rstds[p] = 0.f; }
                for (int t = (RST[c] >> 8) + F.tid; t < (pend >> 8); t += NTHREADS) tilecls[t] = c;
            }
            if (F.tid == 0) tilecls[448] = RST[24] >> 8;
        }
        __syncthreads();
    }
}

__device__ __forceinline__ void cls_experts(int c, int& elo, int& ehi) {
    const int g = c / 6, p = c - g * 6;
    const int lo = p < 3 ? 0 : (p < 5 ? 1 : 2), hi = p < 3 ? p + 1 : (p < 5 ? p - 1 : 3);
    elo = g * 4 + lo; ehi = g * 4 + hi;
}
struct ProbMoeUp {
    g8::StaticOrder S; int wave; const int* tilecls; const int* tokpos; const bf16_t* A; const bf16_t* Bt; bf16_t* H; const float* rstds; const float* wlos; const float* whis;
    __device__ __forceinline__ bool next(int i, g8::Unit& u) const { return S.next(i, u); }
    __device__ __forceinline__ void setup(const g8::Unit& u, g8::GemmIn& gi) const { int R0, R1, C; g8::stage_coords_now(wave, R0, R1, C);
        int elo, ehi; cls_experts(__builtin_amdgcn_readfirstlane(tilecls[u.pm]), elo, ehi);
        const int e = u.pn < 4 ? elo : ehi;
        gi.rA = G8_RSRC(A); gi.sA = 0u; gi.hstepA = 0u; gi.va[0] = 0u; gi.va[1] = 0u;
#pragma unroll
        for (int h = 0; h < 2; ++h) { int t0 = tokpos[u.pm * 256 + h * 128 + R0], t1 = tokpos[u.pm * 256 + h * 128 + R1]; t0 = t0 < 0 ? 0 : t0; t1 = t1 < 0 ? 0 : t1;
            gi.vg[h][0] = (unsigned)(t0 * DM + C) * 2u; gi.vg[h][1] = (unsigned)(t1 * DM + C) * 2u; }
        const unsigned br = (unsigned)e * 1024u + (u.pn & 3) * 256u; g8::set_B(gi, Bt, Bt, br, br, 16, DM, R0, R1, C);
    }
    __device__ __forceinline__ g8::EpiGateUp epi(const g8::Unit& u) const { return g8::EpiGateUp{H, rstds, u.pn < 4 ? wlos : whis, u.pm * 256, u.pn * 128}; }
};
template <bool NEXTPREP> struct ProbMoeDown {
    g8::StaticOrder S; int wave; const int* tilecls; const int* tokpos; const bf16_t* A; const bf16_t* Bt; const bf16_t* xres; float* out; bf16_t* xb; float* ssq;
    __device__ __forceinline__ bool next(int i, g8::Unit& u) const { return S.next(i, u); }
    __device__ __forceinline__ void setup(const g8::Unit& u, g8::GemmIn& gi) const { int R0, R1, C; g8::stage_coords_now(wave, R0, R1, C);
        int elo, ehi; cls_experts(__builtin_amdgcn_readfirstlane(tilecls[u.pm]), elo, ehi);
        g8::set_A_rows(gi, A, u.pm * 256, DM, R0, R1, C);
        g8::set_B(gi, Bt, Bt, (unsigned)elo * 1024u + u.pn * 256u, (unsigned)ehi * 1024u + u.pn * 256u, 8, 512, R0, R1, C);
    }
    __device__ __forceinline__ g8::EpiResidT<true, !NEXTPREP> epi(const g8::Unit& u) const { return g8::EpiResidT<true, !NEXTPREP>{xres, out, xb, tokpos, NEXTPREP ? ssq : nullptr, u.pm * 256, u.pn * 256}; }
};
__device__ __forceinline__ void phase_moe_up(Frame& F, int l) {
    bf16_t* WB = WSP(bf16_t, WS_W + (size_t)l * W_STRIDE);
    ProbMoeUp pb; pb.wave = F.wave;
    pb.tilecls = WSP(int, WS_TILECLS); pb.tokpos = WSP(int, WS_TOKPOS);
    pb.S.init(__builtin_amdgcn_readfirstlane(pb.tilecls[448]), 8, GRID, F.bid);
    pb.A = WSP(bf16_t, WS_XB2); pb.Bt = WB + W_GU / 2; pb.H = WSP(bf16_t, WS_H); pb.rstds = WSP(float, WS_RSTDS); pb.wlos = WSP(float, WS_WLOS); pb.whis = WSP(float, WS_WHIS);
    g8::gemm_units<true>(F.lds, F.wave, F.lane, pb);
}
template <bool NEXTPREP> __device__ __forceinline__ void moe_down_t(Frame& F, int l) {
    bf16_t* WB = WSP(bf16_t, WS_W + (size_t)l * W_STRIDE);
    ProbMoeDown<NEXTPREP> pb; pb.wave = F.wave;
    pb.tilecls = WSP(int, WS_TILECLS); pb.tokpos = WSP(int, WS_TOKPOS);
    pb.S.init(__builtin_amdgcn_readfirstlane(pb.tilecls[448]), 4, GRID, F.bid);
    pb.A = WSP(bf16_t, WS_H); pb.Bt = WB + W_DN / 2; pb.xres = WSP(bf16_t, WS_XB2); pb.out = F.out; pb.xb = (bf16_t*)((char*)F.out + DO_XB); pb.ssq = WSP(float, WS_SSQ);
    g8::gemm_units<false>(F.lds, F.wave, F.lane, pb);
}
__device__ __forceinline__ void phase_moe_down(Frame& F, int l) {
    if (l == 0) { moe_down_t<true>(F, l); refresh(F); memkv_gemm(F, 1, GRID - 1 - F.bid); }
    else moe_down_t<false>(F, l);
}

#if SELFTEST
#define ST_NCHK 40
#define ST_ACC(F) ((float*)((F).ws + WS_CTL + 512 * KiB))
__device__ __forceinline__ void st_add(float* acc, int chk, float mine, float ref) { const float d = mine - ref; atomicAdd(&acc[chk * 2], d * d); atomicAdd(&acc[chk * 2 + 1], ref * ref); }

__device__ void st_rwprep(Frame& F, int tok, int l) {
    const bf16_t* P = WSP(bf16_t, WS_P); float* acc = ST_ACC(F);
    const float* mup = F.in[7] + l * 1152; const float* mun = F.in[8] + l * 1152; const float* w0 = F.in[9] + l * 512; const float* w2 = F.in[10] + (size_t)l * 2 * 64 * 256; const float* a0 = F.in[11] + l * 512; const float* a2 = F.in[12] + (size_t)l * 2 * 64 * 256; const float* g2 = F.in[13] + (size_t)l * 128 * 256;
    const float* k_k = F.in[14] + l * 256; const float* k_a = F.in[15] + l * 256; const float* r_k = F.in[16] + l * 256;
    LAS float* SH = (LAS float*)F.lds;
    LAS float* RD = SH + 1152;
    const int t = tok & (SEQ - 1);
    for (int c = F.tid; c < 1152; c += NTHREADS) {
        const float s = bf2f(P[(size_t)tok * PIN + C_RW + c]);
        const float pv = t == 0 ? 0.f : bf2f(P[(size_t)(tok - 1) * PIN + C_RW + c]);
        const float nx = t == SEQ - 1 ? 0.f : bf2f(P[(size_t)(tok + 1) * PIN + C_RW + c]);
        SH[c] = s + mup[c] * (pv - s) + mun[c] * (nx - s);
    }
    __syncthreads();
    const int c = F.tid & 255;
    float wf = w0[c], wb = w0[256 + c], af = a0[c], ab = a0[256 + c], g = 0.f;
    for (int j = 0; j < 64; ++j) { wf += tanhf(SH[768 + j]) * w2[j * 256 + c]; wb += tanhf(SH[832 + j]) * w2[(64 + j) * 256 + c]; af += SH[896 + j] * a2[j * 256 + c]; ab += SH[960 + j] * a2[(64 + j) * 256 + c]; }
    for (int j = 0; j < 128; ++j) g += (1.0f / (1.0f + expf(-SH[1024 + j]))) * g2[j * 256 + c];
    const float r = SH[c], k = SH[256 + c], v = SH[512 + c];
    const float ef = expf(-log1pf(expf(-wf)) - 0.5f), eb = expf(-log1pf(expf(-wb)) - 0.5f);
    af = 1.0f / (1.0f + expf(-af)); ab = 1.0f / (1.0f + expf(-ab));
    const float kx = k * k_k[c]; const float kdf = k * (1.0f + (af - 1.0f) * k_a[c]), kdb = k * (1.0f + (ab - 1.0f) * k_a[c]);
    if (F.tid < 256) { RD[c] = kx * kx; RD[256 + c] = r * (kdf + kdb) * r_k[c]; }
    __syncthreads();
    float ss = 0.f, bs = 0.f; for (int j = 0; j < 64; ++j) { ss += RD[(c & ~63) + j]; bs += RD[256 + (c & ~63) + j]; }
    const float kk = kx / fmaxf(sqrtf(ss), 1e-12f);
    if (F.tid < 256) {
        const size_t o = (size_t)tok * 256 + c;
        const float ref[10] = {r, k, kk, v, ef, eb, af, ab, g, bs * v};
#pragma unroll
        for (int q = 0; q < 10; ++q) st_add(acc, 0 + q, bf2f(RWBUF(q)[o]), ref[q]);
    }
    __syncthreads();
}
__device__ void st_scan(Frame& F, int b, int h, int dir, int l) {
    if (F.wave != 0) return;
    constexpr int NST = 40; float* acc = ST_ACC(F);
    const int lane = F.lane; const float* k_a = F.in[15] + l * 256;
    float S[64];
#pragma unroll
    for (int k = 0; k < 64; ++k) S[k] = 0.f;
    const bf16_t* Y = (const bf16_t*)(F.ws + WS_Y + (size_t)dir * RWB);
    for (int step = 0; step < NST; ++step) {
        const int t = dir ? SEQ - 1 - step : step; const size_t rowo = ((size_t)b * SEQ + t) * 256 + h * 64;
        const float v = bf2f(RWBUF(3)[rowo + lane]);
        float sa = 0.f;
#pragma unroll
        for (int k = 0; k < 64; ++k) sa -= S[k] * bf2f(RWBUF(2)[rowo + k]);
        float y = 0.f;
#pragma unroll
        for (int k = 0; k < 64; ++k) {
            const float kk = bf2f(RWBUF(2)[rowo + k]), a = bf2f(RWBUF(6 + dir)[rowo + k]), e = bf2f(RWBUF(4 + dir)[rowo + k]), kr = bf2f(RWBUF(1)[rowo + k]), r = bf2f(RWBUF(0)[rowo + k]);
            S[k] = S[k] * expf(-e) + sa * (kk * a) + v * (kr * (1.0f + (a - 1.0f) * k_a[h * 64 + k])); y += S[k] * r; }
        st_add(acc, 10 + dir, bf2f(Y[rowo + lane]), y);
    }
}
__device__ void st_rwpost(Frame& F, int tok, int l) {
    float* acc = ST_ACC(F); LAS float* RD = (LAS float*)F.lds;
    const bf16_t* Yf = (const bf16_t*)(F.ws + WS_Y); const bf16_t* Yb = (const bf16_t*)(F.ws + WS_Y + RWB); const bf16_t* MIX = WSP(bf16_t, WS_XB);
    const int c = F.tid & 255; const size_t o = (size_t)tok * 256 + c;
    const float y = bf2f(Yf[o]) + bf2f(Yb[o]);
    if (F.tid < 256) RD[c] = y;
    __syncthreads();
    float mu = 0.f; for (int j = 0; j < 64; ++j) mu += RD[(c & ~63) + j]; mu *= (1.0f / 64.0f);
    float var = 0.f; for (int j = 0; j < 64; ++j) { const float d = RD[(c & ~63) + j] - mu; var += d * d; } var *= (1.0f / 64.0f);
    const float yn = (y - mu) / sqrtf(var + 64e-5f) * F.in[17][l * 256 + c] + F.in[18][l * 256 + c];
    if (F.tid < 256) st_add(acc, 12, bf2f(MIX[(size_t)tok * DM + 512 + c]), (yn + bf2f(RWBUF(9)[o])) * bf2f(RWBUF(8)[o]));
    __syncthreads();
}
__device__ void st_moe(Frame& F, int tok, int l) {
    float* acc = ST_ACC(F);
    LAS float* X = (LAS float*)F.lds;
    LAS float* HID = X + 1024;
    LAS float* RD = HID + 1024;
    LAS float* LG = RD + 512;
    const bf16_t* xb2 = WSP(bf16_t, WS_XB2); const float* nw = F.in[24] + l * DM;
    float ss = 0.f;
    for (int i = F.tid; i < DM; i += NTHREADS) { const float v = bf2f(xb2[(size_t)tok * DM + i]); X[i] = v; ss += v * v; }
    RD[F.tid] = ss; __syncthreads();
    float tot = 0.f; for (int j = 0; j < NTHREADS; ++j) tot += RD[j];
    const float rs = 1.0f / sqrtf(tot / DM + 1e-6f);
    __syncthreads();
    for (int i = F.tid; i < DM; i += NTHREADS) X[i] = X[i] * rs * nw[i];
    __syncthreads();
    if (F.tid < 20) { float a = 0.f; const int o = F.tid; for (int k = 0; k < DM; ++k) a += X[k] * (o < 4 ? F.in[25][(size_t)l * DM * 4 + k * 4 + o] : F.in[27][(size_t)l * DM * 16 + k * 16 + o - 4]); LG[o] = a + (o < 4 ? F.in[26][l * 4 + o] : F.in[28][l * 16 + o - 4]); }
    __syncthreads();
    int g = 0; for (int o = 1; o < 4; ++o) if (LG[o] > LG[g]) g = o;
    float gs = 0.f; for (int o = 0; o < 4; ++o) gs += expf(LG[o] - LG[g]); const float gw = 1.0f / gs;
    int i1 = 0; for (int o = 1; o < 4; ++o) if (LG[4 + g * 4 + o] > LG[4 + g * 4 + i1]) i1 = o;
    int i2 = -1; for (int o = 0; o < 4; ++o) if (o != i1 && (i2 < 0 || LG[4 + g * 4 + o] > LG[4 + g * 4 + i2])) i2 = o;
    const float p1 = 1.0f / (1.0f + expf(LG[4 + g * 4 + i2] - LG[4 + g * 4 + i1])), p2 = 1.0f - p1;
    const int ee[2] = {g * 4 + i1, g * 4 + i2}; const float ww[2] = {gw * p1, gw * p2};
    for (int s = 0; s < 2; ++s) {
        const float* wg = F.in[29] + ((size_t)l * 16 + ee[s]) * DM * 512; const float* wu = F.in[30] + ((size_t)l * 16 + ee[s]) * DM * 512;
        const int j = F.tid;
        float ga = 0.f, ua = 0.f; for (int k = 0; k < DM; ++k) { ga += X[k] * wg[(size_t)k * 512 + j]; ua += X[k] * wu[(size_t)k * 512 + j]; }
        HID[s * 512 + j] = ga / (1.0f + expf(-ga)) * ua * ww[s];
    }
    __syncthreads();
    for (int n = F.tid; n < DM; n += NTHREADS) {
        float y = 0.f;
        for (int s = 0; s < 2; ++s) { const float* wd = F.in[31] + ((size_t)l * 16 + ee[s]) * 512 * DM; for (int j = 0; j < 512; ++j) y += HID[s * 512 + j] * wd[(size_t)j * DM + n]; }
        st_add(acc, 14, F.out[(size_t)tok * DM + n] - bf2f(xb2[(size_t)tok * DM + n]), y);
    }
    if (F.tid == 0) { const int lo = i1 < i2 ? i1 : i2, hi = i1 < i2 ? i2 : i1; const int pair = lo == 0 ? hi - 1 : (lo == 1 ? hi + 1 : 5);
        const int mine = WSP(int, WS_CLS)[tok]; atomicAdd(&acc[13 * 2], mine == g * 6 + pair ? 0.f : 1.f); atomicAdd(&acc[13 * 2 + 1], 1.f); }
    __syncthreads();
}

__device__ void st_g1(Frame& F, int tok, int l) {
    float* acc = ST_ACC(F); LAS float* X = (LAS float*)F.lds; LAS float* RD = X + 1024;
    const float* xs = (l == 0 ? F.in[0] : F.out) + (size_t)tok * DM; const float* nw = F.in[2] + l * DM; const float* w = F.in[3] + (size_t)l * DM * PIN;
    float ss = 0.f; for (int i = F.tid; i < DM; i += NTHREADS) { const float v = xs[i]; X[i] = v * nw[i]; ss += v * v; }
    RD[F.tid] = ss; __syncthreads();
    float tot = 0.f; for (int j = 0; j < NTHREADS; ++j) tot += RD[j];
    const float rs = 1.0f / sqrtf(tot / DM + 1e-6f);
    for (int col = F.tid; col < PIN; col += NTHREADS) { float a = 0.f; for (int k = 0; k < DM; ++k) a += X[k] * w[(size_t)k * PIN + col]; st_add(acc, 15, bf2f(WSP(bf16_t, WS_P)[(size_t)tok * PIN + col]), a * rs); }
    __syncthreads();
}
__device__ void st_memkv(Frame& F, int row, int l) {
    float* acc = ST_ACC(F); LAS float* X = (LAS float*)F.lds; LAS float* RD = X + 1024;
    const float* xs = F.in[1] + (size_t)row * DM; const float* nw = F.in[19] + l * DM; const float* w = F.in[20] + (size_t)l * DM * 512;
    float ss = 0.f; for (int i = F.tid; i < DM; i += NTHREADS) { const float v = xs[i]; X[i] = v * nw[i]; ss += v * v; }
    RD[F.tid] = ss; __syncthreads();
    float tot = 0.f; for (int j = 0; j < NTHREADS; ++j) tot += RD[j];
    const float rs = 1.0f / sqrtf(tot / DM + 1e-6f);
    { const int col = F.tid; float a = 0.f; for (int k = 0; k < DM; ++k) a += X[k] * w[(size_t)k * 512 + col]; st_add(acc, 16, bf2f(WSP(bf16_t, WS_MEMKV)[(size_t)row * 512 + col]), a * rs); }
    __syncthreads();
}
__device__ void st_na(Frame& F, int tok, int l) {
    float* acc = ST_ACC(F); const bf16_t* P = WSP(bf16_t, WS_P);
    const int h = F.tid >> 6, d = F.tid & 63; const int b = tok >> 13, sidx = tok & (SEQ - 1), r = sidx >> 6, c = sidx & 63;
    const float* wq = F.in[4] + l * 64; const float* wk = F.in[5] + l * 64; const float* rpb = F.in[6] + (size_t)l * 8 * 15 * 31;
    float q[64]; float ss = 0.f;
#pragma unroll
    for (int i = 0; i < 64; ++i) { q[i] = bf2f(P[(size_t)tok * PIN + h * 64 + i]); ss += q[i] * q[i]; }
    { const float rs = 1.0f / sqrtf(ss / 64.0f + 1e-6f);
#pragma unroll
      for (int i = 0; i < 64; ++i) q[i] = q[i] * rs * wq[i]; }
    const int rs0 = min(max(r - 4, 0), 120), cs0 = min(max(c - 8, 0), 48);
    float mx = -1e30f;
    for (int pass = 0; pass < 2; ++pass) {
        float den = 0.f, o = 0.f;
        for (int n = 0; n < 8; ++n) for (int m = 0; m < 16; ++m) {
            const size_t kt = (size_t)b * SEQ + (rs0 + n) * 64 + cs0 + m; const bf16_t* kp = P + kt * PIN + C_K + h * 64;
            float ks = 0.f, dt = 0.f;
#pragma unroll
            for (int i = 0; i < 64; ++i) { const float kv = bf2f(kp[i]); ks += kv * kv; dt += q[i] * kv * wk[i]; }
            const float s = dt / sqrtf(ks / 64.0f + 1e-6f) * 0.125f + rpb[((size_t)h * 15 + (rs0 + n - r + 7)) * 31 + (cs0 + m - c + 15)];
            if (pass == 0) mx = fmaxf(mx, s); else { const float p = expf(s - mx); den += p; o += p * bf2f(P[kt * PIN + C_V + h * 64 + d]); }
        }
        if (pass == 1) st_add(acc, 17, bf2f(WSP(bf16_t, WS_XB)[(size_t)tok * DM + h * 64 + d]), o / den);
    }
}
__device__ void st_mem(Frame& F, int tok, int l) {
    if (F.tid >= 256) return;
    float* acc = ST_ACC(F); const bf16_t* P = WSP(bf16_t, WS_P); const bf16_t* MKV = WSP(bf16_t, WS_MEMKV);
    const int h = F.tid >> 6, d = F.tid & 63; const int b = tok >> 13;
    const float* wq = F.in[21] + l * 64; const float* wk = F.in[22] + l * 64;
    float q[64]; float ss = 0.f;
#pragma unroll
    for (int i = 0; i < 64; ++i) { q[i] = bf2f(P[(size_t)tok * PIN + C_MQ + h * 64 + i]); ss += q[i] * q[i]; }
    { const float rs = 1.0f / sqrtf(ss / 64.0f + 1e-6f);
#pragma unroll
      for (int i = 0; i < 64; ++i) q[i] = q[i] * rs * wq[i]; }
    float mx = -1e30f;
    for (int pass = 0; pass < 2; ++pass) {
        float den = 0.f, o = 0.f;
        for (int m = 0; m < NMEM; ++m) {
            const bf16_t* kp = MKV + ((size_t)b * NMEM + m) * 512 + h * 64;
            float ks = 0.f, dt = 0.f;
#pragma unroll
            for (int i = 0; i < 64; ++i) { const float kv = bf2f(kp[i]); ks += kv * kv; dt += q[i] * kv * wk[i]; }
            const float s = dt / sqrtf(ks / 64.0f + 1e-6f) * 0.125f;
            if (pass == 0) mx = fmaxf(mx, s); else { const float p = expf(s - mx); den += p; o += p * bf2f(kp[256 + d]); }
        }
        if (pass == 1) st_add(acc, 18, bf2f(WSP(bf16_t, WS_XB)[(size_t)tok * DM + 768 + h * 64 + d]), o / den);
    }
}
__device__ void st_g3(Frame& F, int tok) {
    float* acc = ST_ACC(F); const bf16_t* MIX = WSP(bf16_t, WS_XB); const float* w = F.in[23];
    for (int col = F.tid; col < DM; col += NTHREADS) { float a = 0.f; for (int k = 0; k < DM; ++k) a += bf2f(MIX[(size_t)tok * DM + k]) * w[(size_t)k * DM + col];
        st_add(acc, 19, bf2f(WSP(bf16_t, WS_XB2)[(size_t)tok * DM + col]), F.in[0][(size_t)tok * DM + col] + a); }
}
__device__ void st_scan_full(Frame& F, int b, int h, int dir, int l) {
    if (F.wave != 0) return;
    float* acc = ST_ACC(F); const int lane = F.lane; const float* k_a = F.in[15] + l * 256;
    float S[64];
#pragma unroll
    for (int k = 0; k < 64; ++k) S[k] = 0.f;
    const bf16_t* Y = (const bf16_t*)(F.ws + WS_Y + (size_t)dir * RWB);
    float num = 0.f, den = 0.f;
    for (int step = 0; step < SEQ; ++step) {
        const int t = dir ? SEQ - 1 - step : step; const size_t rowo = ((size_t)b * SEQ + t) * 256 + h * 64;
        const float v = bf2f(RWBUF(3)[rowo + lane]);
        float sa = 0.f;
#pragma unroll
        for (int k = 0; k < 64; ++k) sa -= S[k] * bf2f(RWBUF(2)[rowo + k]);
        float y = 0.f;
#pragma unroll
        for (int k = 0; k < 64; ++k) {
            const float kk = bf2f(RWBUF(2)[rowo + k]), a = bf2f(RWBUF(6 + dir)[rowo + k]), e = bf2f(RWBUF(4 + dir)[rowo + k]), kr = bf2f(RWBUF(1)[rowo + k]), r = bf2f(RWBUF(0)[rowo + k]);
            S[k] = S[k] * expf(-e) + sa * (kk * a) + v * (kr * (1.0f + (a - 1.0f) * k_a[h * 64 + k])); y += S[k] * r; }
        const float dd = bf2f(Y[rowo + lane]) - y; num += dd * dd; den += y * y;
    }
    atomicAdd(&acc[(20 + dir) * 2], num); atomicAdd(&acc[(20 + dir) * 2 + 1], den);
}
__global__ void __launch_bounds__(NTHREADS, 2) selftest_k(Args args, int part, int l) {
    extern __shared__ __attribute__((aligned(16))) unsigned char lds_raw[];
    Frame F; F.lds = (LAS unsigned char*)lds_raw; F.bid = blockIdx.x; F.wave = __builtin_amdgcn_readfirstlane((int)(threadIdx.x >> 6)); refresh(F);
    const int bid = F.bid;
    const int tok = (int)(((unsigned)bid * 2654435761u) >> 16) & (NT - 1);
    if (part == 0) {
        if (bid < 96) st_rwprep(F, bid < 4 ? (bid & 1 ? SEQ - 1 : 0) + (bid >> 1) * SEQ * 3 : tok, l);
        else if (bid < 100) st_scan(F, (bid - 96) * 2 + 1, bid & 3, 0, l);
        else if (bid < 104) st_scan(F, (bid - 100) * 2, (bid + 1) & 3, 1, l);
        else if (bid < 168) st_rwpost(F, tok, l);
        else if (bid < 200) st_g1(F, tok, l);
        else if (bid < 216) st_memkv(F, tok & (NMROWS - 1), l);
        else if (bid < 280) st_na(F, bid < 224 ? ((bid & 1) ? 63 : 0) + ((bid >> 1) & 3) * SEQ * 2 + ((bid >> 1) & 1 ? (SEQ - 64) : 0) : tok, l);
        else if (bid < 312) st_mem(F, tok, l);
        else if (bid < 316) st_scan_full(F, (bid * 3) & 7, bid & 3, bid & 1, l);
    } else { if (bid < 64) st_moe(F, tok, l); else if (bid < 96 && l == 0) st_g3(F, tok); }
}
__global__ void selftest_encode(Args args, int first, int last, float thr) {
    const float* acc = (const float*)((unsigned char*)args.tab[33] + WS_CTL + 512 * KiB);
    float s = 1.0f;
    for (int c = last; c >= first; --c) { const float num = acc[c * 2], den = acc[c * 2 + 1]; const bool bad = (c == 13) ? (num > 0.08f * den) : !(num <= thr * thr * den); if (bad || den == 0.f) s = -(float)(1 + c - first); }
#if defined(ST_MAG)
    { const float num = acc[ST_MAG * 2], den = acc[ST_MAG * 2 + 1]; float dl = sqrtf(num / fmaxf(den, 1e-30f)); dl = fminf(dl, 0.6f); s = -(1.0f + rintf(dl * 100.0f)); if (!(den > 0.f)) s = -80.f; }
#endif
    const float* x = args.tab[0]; float* out = (float*)args.tab[32];
    for (size_t i = (size_t)blockIdx.x * blockDim.x + threadIdx.x; i < (size_t)NT * DM; i += (size_t)gridDim.x * blockDim.x) out[i] = x[i] * s;
}
#endif

__global__ void __launch_bounds__(NTHREADS, 2) fwd(Args args) {
    extern __shared__ __attribute__((aligned(16))) unsigned char lds_raw[];
    Frame F;
    F.lds = (LAS unsigned char*)lds_raw; F.bid = blockIdx.x; F.wave = __builtin_amdgcn_readfirstlane((int)(threadIdx.x >> 6));
    refresh(F); F.dup = 0;
    volatile LAS unsigned* xbw = (volatile LAS unsigned*)(F.lds + LDS_MISC);
    if (F.tid < 4) xbw[F.tid] = 0u;
    __syncthreads();
    const int lo = args.ph_lo, hi = args.ph_hi;
    const bool multi = (hi - lo) > 1;
    XcdBarrier bar; bar.bar = (unsigned*)(F.ws + WS_CTL); bar.x = 0; bar.st = xbw;
    if (multi) bar = xcd_barrier_post((unsigned*)(F.ws + WS_CTL), xbw, F.tid == 0);
#ifndef ONLY_PH
#define ONLY_PH -1
#endif
#define IN(k) (lo <= (k) && (k) < hi)
#define EN(k) (ONLY_PH < 0 || ONLY_PH == (k))
#define SEAM(k) do { if (IN(k) && IN((k) + 1)) { refresh(F); xcd_barrier(bar, F.tid == 0); } } while (0)
#if EXTRA_BARS
    for (int eb = 0; eb < EXTRA_BARS; ++eb) { refresh(F); xcd_barrier(bar, F.tid == 0); }
#endif
#define PHASE(k, call) do { if (EN(k) && IN(pb + (k))) { refresh(F); call; if (DUP_PH == (k) && l == 0) { refresh(F); xcd_barrier(bar, F.tid == 0); refresh(F); F.dup = 1; call; F.dup = 0; } } SEAM(pb + (k)); } while (0)
    for (int l = 0; l < 2; ++l) {
        const int pb = l * NPH;
        if (l == 0) { if (EN(0) && IN(pb + 0)) { refresh(F); phase_prep(F, l); }
        SEAM(pb + 0); }
        PHASE(1, phase_inproj(F, l));
        PHASE(2, phase_rwprep(F, l));
        PHASE(3, phase_scanmix(F, l));
        PHASE(4, phase_rwpost(F, l));
        PHASE(5, phase_outproj(F, l));
        PHASE(6, phase_router(F, l));
        PHASE(7, phase_scatter(F, l));
        PHASE(8, phase_moe_up(F, l));
        PHASE(9, phase_moe_down(F, l));
    }
#undef PHASE
#undef IN
#undef SEAM
}

extern "C" void kernel_launch(void* const* d_in, const int* in_sizes, int n_in, void* d_out, int out_size, void* d_ws, size_t ws_size, hipStream_t stream) {
    static int grid = 0;
    if (grid == 0) {
        if (n_in != 32 || in_sizes[0] != NT * DM || out_size != NT * DM || ws_size < WS_END) {
            fprintf(stderr, "kernel_launch: unexpected shapes: n_in %d in0 %d out %d ws %zu (need %zu)\n", n_in, n_in > 0 ? in_sizes[0] : -1, out_size, ws_size, (size_t)WS_END); grid = -1; return; }
        int dev = 0, cus = 0, per_cu = 0;
        if (hipGetDevice(&dev) != hipSuccess || hipDeviceGetAttribute(&cus, hipDeviceAttributeMultiprocessorCount, dev) != hipSuccess) { grid = -1; return; }
        if (hipFuncSetAttribute((const void*)fwd, hipFuncAttributeMaxDynamicSharedMemorySize, LDS_BYTES) != hipSuccess) { fprintf(stderr, "kernel_launch: hipFuncSetAttribute failed\n"); grid = -1; return; }
        if (hipOccupancyMaxActiveBlocksPerMultiprocessor(&per_cu, (const void*)fwd, NTHREADS, LDS_BYTES) != hipSuccess || per_cu < 1)
            fprintf(stderr, "kernel_launch: occupancy query says %d blocks per CU\n", per_cu);
        (void)hipGetLastError();
        if (cus < GRID) { fprintf(stderr, "kernel_launch: built for %d CUs, device has %d\n", GRID, cus); grid = -1; return; }
        grid = GRID;
    }
    if (grid < 0) return;
    (void)hipMemsetAsync((char*)d_ws + WS_CTL, 0, 1 * MiB, stream);
    Args a{};
    for (int i = 0; i < 32; ++i) a.tab[i] = (const float*)d_in[i];
    a.tab[32] = (const float*)d_out; a.tab[33] = (const float*)d_ws;
#if MK_ONE_LAUNCH
    a.ph_lo = 0; a.ph_hi = 2 * NPH;
    hipLaunchKernelGGL(fwd, dim3(grid), dim3(NTHREADS), LDS_BYTES, stream, a);
#else
#if SELFTEST
    { static bool once = false; if (!once) { once = true; (void)hipFuncSetAttribute((const void*)selftest_k, hipFuncAttributeMaxDynamicSharedMemorySize, LDS_BYTES); } }
    for (int p = 0; p < NPH; ++p) { a.ph_lo = p; a.ph_hi = p + 1; hipLaunchKernelGGL(fwd, dim3(grid), dim3(NTHREADS), LDS_BYTES, stream, a);
        if (p == 6) hipLaunchKernelGGL(selftest_k, dim3(316), dim3(NTHREADS), LDS_BYTES, stream, a, 0, 0); }
    hipLaunchKernelGGL(selftest_k, dim3(96), dim3(NTHREADS), LDS_BYTES, stream, a, 1, 0);
    hipLaunchKernelGGL(selftest_encode, dim3(2048), dim3(256), 0, stream, a, ST_FIRST, ST_LAST, 0.05f);
    return;
#endif
    for (int p = 0; p < 2 * NPH; ++p) { a.ph_lo = p; a.ph_hi = p + 1; hipLaunchKernelGGL(fwd, dim3(grid), dim3(NTHREADS), LDS_BYTES, stream, a); }
#endif
}
```

```cpp
#include <hip/hip_runtime.h>
#include <cstdio>
#include <cstdint>

#define LAS __attribute__((address_space(3)))
typedef unsigned short bf16_t;
typedef short bf16x8 __attribute__((ext_vector_type(8)));
typedef float f32x4 __attribute__((ext_vector_type(4)));
typedef unsigned u32x2 __attribute__((ext_vector_type(2)));
typedef unsigned u32x4 __attribute__((ext_vector_type(4)));

#ifndef EXTRA_BARS
#define EXTRA_BARS 0
#ifndef SCAN_VAR
#define SCAN_VAR 0
#endif
#endif
#ifndef DYN_GEMM
#define DYN_GEMM 0
#endif
#ifndef EPI_REP
#define EPI_REP 1
#endif
#ifndef KLOOP_REP
#define KLOOP_REP 1
#endif
#ifndef DUP_PH
#define DUP_PH -1
#endif
#ifndef NAIVE_SCAN
#define NAIVE_SCAN 0
#endif
#ifndef BRUTE_ATTN
#define BRUTE_ATTN 0
#endif
#ifndef SELFTEST
#define SELFTEST 0
#endif
#ifndef ST_FIRST
#define ST_FIRST 18
#endif
#ifndef ST_LAST
#define ST_LAST 21
#endif
#ifndef ABL
#define ABL 0
#endif
#ifndef MK_ONE_LAUNCH
#define MK_ONE_LAUNCH 1
#endif

constexpr int NB = 8, SEQ = 8192, DM = 1024, NT = NB * SEQ, NMEM = 256, NMROWS = NB * NMEM;
constexpr int PIN = 2944, PINP = 3072;
constexpr int PA_LD = 1792, PR_LD = 1152;
constexpr int C_K = 512, C_V = 1024, C_MQ = 1536;
constexpr int SRC_RW = 1536, SRC_MQ = 2688;
constexpr int MPAD = NT + 24 * 256;
constexpr int NWAVES = 8, NTHREADS = 512, GRID = 256;
constexpr int LDS_BYTES = 148 * 1024;
constexpr int LDS_RPB = 146 * 1024;
constexpr int LDS_MISC = 145 * 1024;
constexpr int NPH = 10;

constexpr size_t MiB = 1u << 20, KiB = 1u << 10;
constexpr size_t WS_CTL = 0;
constexpr size_t WS_RSTDX = 1 * MiB;
constexpr size_t WS_RSTDM = WS_RSTDX + 256 * KiB;
constexpr size_t WS_CLS = WS_RSTDM + 64 * KiB;
constexpr size_t WS_WLO = WS_CLS + 256 * KiB;
constexpr size_t WS_WHI = WS_WLO + 256 * KiB;
constexpr size_t WS_RSTD2 = WS_WHI + 256 * KiB;
constexpr size_t WS_HIST = WS_RSTD2 + 256 * KiB;
constexpr size_t WS_TOKPOS = WS_HIST + 64 * KiB;
constexpr size_t WS_WLOS = WS_TOKPOS + 320 * KiB;
constexpr size_t WS_WHIS = WS_WLOS + 320 * KiB;
constexpr size_t WS_RSTDS = WS_WHIS + 320 * KiB;
constexpr size_t WS_TILECLS = WS_RSTDS + 320 * KiB;
constexpr size_t WS_WR = WS_TILECLS + 64 * KiB;
constexpr size_t WS_SMALL_END = WS_WR + 128 * KiB;
static_assert(WS_SMALL_END <= 4 * MiB, "small region");
constexpr size_t WS_LORA = 4 * MiB;
constexpr size_t LORA_STRIDE = 256 * KiB;
constexpr size_t WS_WR2 = 5 * MiB, WR_STRIDE = 256 * KiB;
constexpr size_t WS_SSQ = 6 * MiB;
constexpr size_t WS_SSQ2 = 7 * MiB;
constexpr size_t WS_W = 8 * MiB, W_STRIDE = 60 * MiB;
constexpr size_t W_IN = 0;
constexpr size_t W_MEM = W_IN + (size_t)PINP * DM * 2;
constexpr size_t W_OUT = W_MEM + (size_t)512 * DM * 2;
constexpr size_t W_GU = W_OUT + (size_t)DM * DM * 2;
constexpr size_t W_DN = W_GU + (size_t)16 * DM * DM * 2;
constexpr size_t W_END = W_DN + (size_t)16 * DM * 512 * 2;
static_assert(W_END <= 60 * MiB, "weights region");
constexpr size_t WS_MEMB = WS_W + 120 * MiB;
constexpr size_t WS_MEMKV = WS_MEMB + 4 * MiB;
constexpr size_t DO_MIX = 0, DO_XB = 128 * MiB;
constexpr size_t WS_PA = WS_MEMKV + 2 * MiB;
constexpr size_t WS_PR = WS_PA + 224 * MiB;
constexpr size_t WS_CH = WS_PR + 160 * MiB;
constexpr size_t WS_XB2 = WS_PA;
constexpr size_t WS_H = WS_CH;
constexpr size_t WS_RW = WS_CH + 320 * MiB;
constexpr size_t RWB = (size_t)NT * 256 * 2;
constexpr size_t WS_Y = WS_RW + 3 * RWB;
constexpr size_t WS_END = WS_RW + 5 * RWB;
static_assert((size_t)MPAD * DM * 2 <= 320 * MiB, "H fits");
static_assert((size_t)NT * PA_LD * 2 <= 224 * MiB && (size_t)NT * PR_LD * 2 <= 320 * MiB, "P fits");

__device__ __forceinline__ float bf2f(bf16_t v) { return __uint_as_float(((unsigned)v) << 16); }
typedef __bf16 hwbf16x2 __attribute__((ext_vector_type(2)));
__device__ __forceinline__ bf16_t f2bf(float f) { return __builtin_bit_cast(bf16_t, (__bf16)f); }
__device__ __forceinline__ unsigned pk2(float lo, float hi) { hwbf16x2 v; v.x = (__bf16)lo; v.y = (__bf16)hi; return __builtin_bit_cast(unsigned, v); }
__device__ __forceinline__ float bflo(unsigned u) { return __uint_as_float(u << 16); }
__device__ __forceinline__ float bfhi(unsigned u) { return __uint_as_float(u & 0xffff0000u); }
__device__ __forceinline__ void unpack8(const u32x4 v, float* f) { f[0] = bflo(v.x); f[1] = bfhi(v.x); f[2] = bflo(v.y); f[3] = bfhi(v.y); f[4] = bflo(v.z); f[5] = bfhi(v.z); f[6] = bflo(v.w); f[7] = bfhi(v.w); }
__device__ __forceinline__ bf16x8 pack8(const float* f) { u32x4 w; w.x = pk2(f[0], f[1]); w.y = pk2(f[2], f[3]); w.z = pk2(f[4], f[5]); w.w = pk2(f[6], f[7]); return __builtin_bit_cast(bf16x8, w); }
__device__ __forceinline__ float wave_sum(float v) {
#pragma unroll
    for (int o = 32; o >= 1; o >>= 1) v += __shfl_xor(v, o);
    return v;
}
__device__ __forceinline__ float sigmoidf_(float x) { return __builtin_amdgcn_rcpf(1.0f + __expf(-x)); }

#define XB_TMO      128
#define XB_XCNT(j)  (256  + 64 * (j))
#define XB_XSUB(j)  (1280 + 64 * (j))
#define XB_XGEN(j)  (2304 + 64 * (j))
#define XB_TOP      3328
#define XB_TOPGEN   3392
#define XCD_BAR_WORDS 3456
#define XB_SPIN_CAP (1u << 18)

__device__ __forceinline__ unsigned xb_ld(unsigned* p)              { return __hip_atomic_load(p, __ATOMIC_RELAXED, __HIP_MEMORY_SCOPE_AGENT); }
__device__ __forceinline__ unsigned xb_add(unsigned* p, unsigned v) { return __hip_atomic_fetch_add(p, v, __ATOMIC_RELAXED, __HIP_MEMORY_SCOPE_AGENT); }
__device__ __forceinline__ unsigned xb_xcc_id() { return (unsigned)__builtin_amdgcn_s_getreg((3 << 11) | 20) & 0xFu; }
#define XB_SPIN(cond, bar) do { unsigned _sp = 0; while (cond) { __builtin_amdgcn_s_sleep(1); \
    if ((++_sp & 255u) == 0u) { if (xb_ld(&(bar)[XB_TMO])) break; if (_sp > XB_SPIN_CAP) { atomicAdd(&(bar)[XB_TMO], 1u); break; } } } } while (0)

struct XcdBarrier { unsigned* bar; unsigned x; volatile LAS unsigned* st; };

__device__ __forceinline__ XcdBarrier xcd_barrier_post(unsigned* bar, volatile LAS unsigned* st, bool leader  ) {
    XcdBarrier b; b.bar = bar; b.x = xb_xcc_id(); b.st = st;
    if (leader) (void)xb_add(&bar[XB_XCNT(b.x)], 1u);
    return b;
}
__device__ __forceinline__ void xcd_barrier_complete(unsigned* bar, unsigned x, unsigned& nloc, unsigned& nx) {
    const unsigned G = gridDim.x * gridDim.y * gridDim.z;
    unsigned sum, cnt, mine, sp = 0u;
    for (;;) {
        sum = 0u; cnt = 0u; mine = 0u;
#pragma unroll
        for (unsigned j = 0; j < 16; ++j) { const unsigned c = xb_ld(&bar[XB_XCNT(j)]); sum += c; cnt += (c > 0u) ? 1u : 0u; mine = (j == x) ? c : mine; }
        if (sum == G) break;
        __builtin_amdgcn_s_sleep(1);
        if ((++sp & 255u) == 0u) { if (xb_ld(&bar[XB_TMO])) break; if (sp > XB_SPIN_CAP) { atomicAdd(&bar[XB_TMO], 1u); break; } }
    }
    nloc = mine > 0u ? mine : 1u; nx = cnt > 0u ? cnt : 1u;
}
__device__ __forceinline__ void xcd_barrier(const XcdBarrier& b, bool leader  ) {
    asm volatile("s_waitcnt vmcnt(0)" ::: "memory");
    __syncthreads();
    if (leader) {
        unsigned* bar = b.bar;
        __builtin_amdgcn_s_waitcnt(0);
        unsigned nloc = b.st[0], nx = b.st[1];
        if (nloc == 0u) { xcd_barrier_complete(bar, b.x, nloc, nx); b.st[0] = nloc; b.st[1] = nx; }
        const unsigned old = xb_add(&bar[XB_XSUB(b.x)], 1u);
        const unsigned gen = old / nloc;
        if (old + 1u == (gen + 1u) * nloc) {
            __builtin_amdgcn_fence(__ATOMIC_RELEASE, "agent");
            asm volatile("s_waitcnt vmcnt(0)" ::: "memory");
            const unsigned og = xb_add(&bar[XB_TOP], 1u);
            const unsigned tg = og / nx;
            if (og + 1u == (tg + 1u) * nx) xb_add(&bar[XB_TOPGEN], 1u);
            else XB_SPIN(xb_ld(&bar[XB_TOPGEN]) == tg, bar);
            __builtin_amdgcn_fence(__ATOMIC_ACQUIRE, "agent");
            xb_add(&bar[XB_XGEN(b.x)], 1u);
            asm volatile("s_waitcnt vmcnt(0)" ::: "memory");
        } else {
            XB_SPIN(xb_ld(&bar[XB_XGEN(b.x)]) == gen, bar);
            __builtin_amdgcn_fence(__ATOMIC_ACQUIRE, "agent");
            asm volatile("s_waitcnt vmcnt(0)" ::: "memory");
        }
    }
    __syncthreads();
}

struct Args {
    const float* tab[34];
    int ph_lo, ph_hi;
};
typedef const float* cfp_t;
typedef __attribute__((address_space(4))) const cfp_t* InTab;
struct Frame {
    InTab in;
    float* out;
    unsigned char* ws;
    LAS unsigned char* lds;
    int tid, lane, wave, bid, dup;
};
__device__ __forceinline__ uintptr_t launder_uniform(uintptr_t p) {
    unsigned lo = (unsigned)p, hi = (unsigned)(p >> 32);
    asm volatile("" : "+v"(lo), "+v"(hi));
    lo = __builtin_amdgcn_readfirstlane(lo); hi = __builtin_amdgcn_readfirstlane(hi);
    return ((uintptr_t)hi << 32) | (uintptr_t)lo;
}
__device__ __forceinline__ void refresh(Frame& F) {
    int ln; asm volatile("v_mbcnt_lo_u32_b32 %0, -1, 0\n\tv_mbcnt_hi_u32_b32 %0, -1, %0" : "=v"(ln));
    F.lane = ln; F.tid = F.wave * 64 + ln;
    F.in = (InTab)launder_uniform((uintptr_t)__builtin_amdgcn_kernarg_segment_ptr());
    F.out = (float*)F.in[32]; F.ws = (unsigned char*)F.in[33];
}

namespace g8 {
constexpr int BM = 256, BK = 64, HALF = 128, HTB = HALF * BK * 2, NXCD = 8, WGM = 8;
__device__ __forceinline__ int lds_byte(int r, int c) { const int st = (r >> 4) * 2 + (c >> 5), rr = r & 15, cc = c & 31, ob = rr * 64 + cc * 2; return st * 1024 + (ob ^ (((ob >> 9) & 1) << 5)); }
__device__ __forceinline__ void stage_rc(int b, int& R, int& C) { const int st = b / 1024, sb = b % 1024, swz = sb ^ (((sb >> 9) & 1) << 5); R = (st >> 1) * 16 + swz / 64; C = (st & 1) * 32 + (swz % 64) / 2; }

struct Unit { int pm, pn; };
struct StaticOrder {
    int nM, nN, nwg, G, c;
    __device__ void init(int nM_, int nN_, int G_, int c_) { nM = nM_; nN = nN_; nwg = nM * nN; G = G_; c = c_; }
    __device__ bool next(int i, Unit& u) const {
        const long L = (long)i * G + c; if (L >= nwg) return false;
        int wgid = (int)L; { const int q = nwg / NXCD, r = nwg % NXCD, xcd = wgid % NXCD, off = wgid / NXCD; wgid = (xcd < r ? xcd * (q + 1) : r * (q + 1) + (xcd - r) * q) + off; }
        const int nig = WGM * nN, gid = wgid / nig, fm = gid * WGM, gsz = (nM - fm) < WGM ? (nM - fm) : WGM;
        u.pm = fm + ((wgid % nig) % gsz); u.pn = (wgid % nig) / gsz; return true;
    }
};

struct GemmIn {
    __amdgpu_buffer_rsrc_t rA, rB0, rB1;
    unsigned sA, hstepA;
    unsigned va[2];
    unsigned vg[2][2];
    unsigned sB0, sB1, hstepB; int ksplit;
    unsigned vb[2];
};
#define G8_RSRC(p) __builtin_amdgcn_make_buffer_rsrc((void*)(p), (short)0, 0x7fffffff, 0x00020000)

#define G8_WAIT_V(n) asm volatile("s_waitcnt vmcnt(" #n ")" ::: "memory")
#define G8_WAIT_L(n) asm volatile("s_waitcnt lgkmcnt(" #n ")" ::: "memory")
#define G8_BAR __builtin_amdgcn_s_barrier()
#define G8_SCHED __builtin_amdgcn_sched_barrier(0)

template <bool GATHER, class Epi>
__device__ __forceinline__ void gemm_unit(LAS unsigned char* lds, int wave_s, int lane_v, const GemmIn& gi, const Epi& epi) {
    constexpr int nt = 16;
    constexpr unsigned kstep = BK * 2;
    const int wid = wave_s, lane = lane_v, wr = wid >> 2, wc = wid & 3, fr = lane & 15, fq = lane >> 4;
    const unsigned ldsw = (unsigned)wid * 1024u;
    const int aoff = lds_byte(wr * 64 + fr, fq * 8), boff = lds_byte(wc * 32 + fr, fq * 8);
#define SA(b, h) (((b) * 2 + (h)) * HTB)
#define SB(b, h) ((4 + (b) * 2 + (h)) * HTB)
#define STAGE(bufoff, rsrc, voff, soff) do { _Pragma("unroll") for (int _i = 0; _i < 2; ++_i) \
        __builtin_amdgcn_raw_ptr_buffer_load_lds(rsrc, (LAS unsigned*)(lds + (bufoff) + ldsw + _i * 8192), 16, (voff)[_i], soff, 0, 0); } while (0)
#define STA(b, h, kt) do { if constexpr (GATHER) STAGE(SA(b, h), gi.rA, gi.vg[h], gi.sA + (unsigned)(kt) * kstep); \
        else STAGE(SA(b, h), gi.rA, gi.va, gi.sA + (h) * gi.hstepA + (unsigned)(kt) * kstep); } while (0)
#define STB(b, h, kt) do { const bool _f = (kt) < gi.ksplit; STAGE(SB(b, h), _f ? gi.rB0 : gi.rB1, gi.vb, (_f ? gi.sB0 + (unsigned)(kt) * kstep : gi.sB1 + (unsigned)((kt) - gi.ksplit) * kstep) + (h) * gi.hstepB); } while (0)
#define LDA(dst, b, h) do { _Pragma("unroll") for (int m = 0; m < 4; ++m) _Pragma("unroll") for (int k = 0; k < 2; ++k) dst[m][k] = *(const LAS bf16x8*)(lds + SA(b, h) + aoff + m * 2048 + k * 1024); } while (0)
#define LDB(dst, b, h) do { _Pragma("unroll") for (int n = 0; n < 2; ++n) _Pragma("unroll") for (int k = 0; k < 2; ++k) dst[n][k] = *(const LAS bf16x8*)(lds + SB(b, h) + boff + n * 2048 + k * 1024); } while (0)
#define MMA(ai, bj, At_, Bt_) do { __builtin_amdgcn_s_setprio(1); \
        _Pragma("unroll") for (int m = 0; m < 4; ++m) _Pragma("unroll") for (int n = 0; n < 2; ++n) _Pragma("unroll") for (int k = 0; k < 2; ++k) \
            acc[ai][bj][m][n] = __builtin_amdgcn_mfma_f32_16x16x32_bf16(Bt_[n][k], At_[m][k], acc[ai][bj][m][n], 0, 0, 0); \
        __builtin_amdgcn_s_setprio(0); } while (0)

    f32x4 acc[2][2][4][2];
    { float z = 0.f; asm volatile("" : "+v"(z));
#pragma unroll
    for (int a = 0; a < 2; ++a)
#pragma unroll
        for (int b = 0; b < 2; ++b)
#pragma unroll
            for (int m = 0; m < 4; ++m)
#pragma unroll
                for (int n = 0; n < 2; ++n) acc[a][b][m][n] = (f32x4){z, z, z, z}; }
    bf16x8 At[4][2], B0[2][2], B1[2][2];
#if KLOOP_REP > 1
    for (int rep_ = 0; rep_ < KLOOP_REP; ++rep_) {
    if (rep_) { float z = 0.f; asm volatile("" : "+v"(z));
#pragma unroll
    for (int a = 0; a < 2; ++a)
#pragma unroll
        for (int b = 0; b < 2; ++b)
#pragma unroll
            for (int m = 0; m < 4; ++m)
#pragma unroll
                for (int n = 0; n < 2; ++n) acc[a][b][m][n] = (f32x4){z, z, z, z}; }
#endif
    float pre_v[4]; epi.pre_load(wid * 64 + lane, pre_v);
    STB(0, 0, 0); STA(0, 0, 0); STB(0, 1, 0); STA(0, 1, 0);
    if (wr == 1) G8_BAR;
    G8_WAIT_V(4); G8_BAR;
    epi.pre_commit(lds, wid * 64 + lane, pre_v);
    STB(1, 0, 1); STA(1, 0, 1); STB(1, 1, 1);
    G8_WAIT_V(6); G8_BAR;
    for (int t = 0; t < nt - 2; t += 2) {
        LDB(B0, 0, 0); G8_SCHED; LDA(At, 0, 0); STA(1, 1, t + 1);
        G8_WAIT_L(8); G8_BAR; G8_WAIT_L(0); MMA(0, 0, At, B0); G8_BAR; G8_SCHED;
        LDB(B1, 0, 1); STB(0, 0, t + 2);
        G8_BAR; G8_WAIT_L(0); MMA(0, 1, At, B1); G8_BAR;
        LDA(At, 0, 1); STA(0, 0, t + 2);
        G8_BAR; G8_WAIT_L(0); MMA(1, 0, At, B0); G8_BAR; G8_SCHED;
        STB(0, 1, t + 2);
        G8_WAIT_V(6); G8_BAR; MMA(1, 1, At, B1); G8_BAR;
        LDB(B0, 1, 0); G8_SCHED; LDA(At, 1, 0); STA(0, 1, t + 2);
        G8_WAIT_L(8); G8_BAR; G8_WAIT_L(0); MMA(0, 0, At, B0); G8_BAR; G8_SCHED;
        LDB(B1, 1, 1); STB(1, 0, t + 3);
        G8_BAR; G8_WAIT_L(0); MMA(0, 1, At, B1); G8_BAR;
        LDA(At, 1, 1); STA(1, 0, t + 3);
        G8_BAR; G8_WAIT_L(0); MMA(1, 0, At, B0); G8_BAR; G8_SCHED;
        STB(1, 1, t + 3);
        G8_WAIT_V(6); G8_BAR; MMA(1, 1, At, B1); G8_BAR;
    }
    { LDB(B0, 0, 0); G8_WAIT_V(0); LDA(At, 0, 0); STA(1, 1, nt - 1);
      G8_BAR; G8_WAIT_L(0); MMA(0, 0, At, B0); G8_BAR;
      LDB(B1, 0, 1); G8_BAR; G8_WAIT_L(0); MMA(0, 1, At, B1); G8_BAR;
      LDA(At, 0, 1); G8_WAIT_V(4); G8_BAR; G8_WAIT_L(0); MMA(1, 0, At, B0); MMA(1, 1, At, B1); G8_BAR; }
    { LDB(B0, 1, 0); LDA(At, 1, 0); G8_WAIT_V(2); G8_BAR; G8_WAIT_L(0); MMA(0, 0, At, B0); G8_BAR;
      LDB(B1, 1, 1); G8_WAIT_V(0); G8_BAR; G8_WAIT_L(0); MMA(0, 1, At, B1); G8_BAR;
      LDA(At, 1, 1); G8_BAR; G8_WAIT_L(0); MMA(1, 0, At, B0); MMA(1, 1, At, B1); G8_BAR; }
    if (wr == 0) G8_BAR;
#if KLOOP_REP > 1
    }
#endif
    { int lane2; asm volatile("v_mbcnt_lo_u32_b32 %0, -1, 0\n\tv_mbcnt_hi_u32_b32 %0, -1, %0" : "=v"(lane2));
      epi(acc, wid >> 2, wid & 3, lane2 & 15, lane2 >> 4, lds);
#if EPI_REP > 1
      if (Epi::REPEATABLE) { G8_WAIT_V(0); epi(acc, wid >> 2, wid & 3, lane2 & 15, lane2 >> 4, lds); }
#endif
    }
    G8_WAIT_V(0);
#undef SA
#undef SB
#undef STAGE
#undef STA
#undef STB
#undef LDA
#undef LDB
#undef MMA
}

template <bool GATHER, class Prob>
__device__ __forceinline__ void gemm_phase(LAS unsigned char* lds, int wave_s, int lane_v, const Prob& pb) {
    constexpr int nt = 16;
    constexpr unsigned kstep = BK * 2;
    const int wid = wave_s, lane = lane_v, wr = wid >> 2, wc = wid & 3, fr = lane & 15, fq = lane >> 4;
    const unsigned ldsw = (unsigned)wid * 1024u;
    const int aoff = lds_byte(wr * 64 + fr, fq * 8), boff = lds_byte(wc * 32 + fr, fq * 8);
#define SA(b, h) (((b) * 2 + (h)) * HTB)
#define SB(b, h) ((4 + (b) * 2 + (h)) * HTB)
#define STAGE(bufoff, rsrc, voff, soff) do { _Pragma("unroll") for (int _i = 0; _i < 2; ++_i) \
        __builtin_amdgcn_raw_ptr_buffer_load_lds(rsrc, (LAS unsigned*)(lds + (bufoff) + ldsw + _i * 8192), 16, (voff)[_i], soff, 0, 0); } while (0)
#define STA(gi, b, h, kt) do { if constexpr (GATHER) STAGE(SA(b, h), (gi).rA, (gi).vg[h], (gi).sA + (unsigned)(kt) * kstep); \
        else STAGE(SA(b, h), (gi).rA, (gi).va, (gi).sA + (h) * (gi).hstepA + (unsigned)(kt) * kstep); } while (0)
#define STB(gi, b, h, kt) do { const bool _f = (kt) < (gi).ksplit; STAGE(SB(b, h), _f ? (gi).rB0 : (gi).rB1, (gi).vb, (_f ? (gi).sB0 + (unsigned)(kt) * kstep : (gi).sB1 + (unsigned)((kt) - (gi).ksplit) * kstep) + (h) * (gi).hstepB); } while (0)
#define LDA(dst, b, h) do { _Pragma("unroll") for (int m = 0; m < 4; ++m) _Pragma("unroll") for (int k = 0; k < 2; ++k) dst[m][k] = *(const LAS bf16x8*)(lds + SA(b, h) + aoff + m * 2048 + k * 1024); } while (0)
#define LDB(dst, b, h) do { _Pragma("unroll") for (int n = 0; n < 2; ++n) _Pragma("unroll") for (int k = 0; k < 2; ++k) dst[n][k] = *(const LAS bf16x8*)(lds + SB(b, h) + boff + n * 2048 + k * 1024); } while (0)
#define MMA(ai, bj, At_, Bt_) do { __builtin_amdgcn_s_setprio(1); \
        _Pragma("unroll") for (int m = 0; m < 4; ++m) _Pragma("unroll") for (int n = 0; n < 2; ++n) _Pragma("unroll") for (int k = 0; k < 2; ++k) \
            acc[ai][bj][m][n] = __builtin_amdgcn_mfma_f32_16x16x32_bf16(Bt_[n][k], At_[m][k], acc[ai][bj][m][n], 0, 0, 0); \
        __builtin_amdgcn_s_setprio(0); } while (0)
#define ZERO_ACC() do { float z = 0.f; asm volatile("" : "+v"(z)); \
        _Pragma("unroll") for (int a = 0; a < 2; ++a) _Pragma("unroll") for (int b = 0; b < 2; ++b) _Pragma("unroll") for (int m = 0; m < 4; ++m) _Pragma("unroll") for (int n = 0; n < 2; ++n) acc[a][b][m][n] = (f32x4){z, z, z, z}; } while (0)
    Unit cur, nxt;
    if (!pb.next(0, cur)) return;
    GemmIn gc, gn; pb.setup(cur, gc);
    f32x4 acc[2][2][4][2];
    ZERO_ACC();
    bf16x8 At[4][2], B0[2][2], B1[2][2];
    STB(gc, 0, 0, 0); STA(gc, 0, 0, 0); STB(gc, 0, 1, 0); STA(gc, 0, 1, 0);
    if (wr == 1) G8_BAR;
    G8_WAIT_V(4); G8_BAR;
    STB(gc, 1, 0, 1); STA(gc, 1, 0, 1); STB(gc, 1, 1, 1);
    G8_WAIT_V(6); G8_BAR;
    for (int ui = 0;; ++ui) {
        const bool has_next = pb.next(ui + 1, nxt);
        if (has_next) pb.setup(nxt, gn); else gn = gc;
        for (int t = 0; t < nt; t += 2) {
            const bool last = (t == nt - 2);
            const GemmIn g2 = last ? gn : gc;
            const int k2 = last ? 0 : t + 2, k3 = k2 + 1;
            LDB(B0, 0, 0); G8_SCHED; LDA(At, 0, 0); STA(gc, 1, 1, t + 1);
            G8_WAIT_L(8); G8_BAR; G8_WAIT_L(0); MMA(0, 0, At, B0); G8_BAR; G8_SCHED;
            LDB(B1, 0, 1); STB(g2, 0, 0, k2);
            G8_BAR; G8_WAIT_L(0); MMA(0, 1, At, B1); G8_BAR;
            LDA(At, 0, 1); STA(g2, 0, 0, k2);
            G8_BAR; G8_WAIT_L(0); MMA(1, 0, At, B0); G8_BAR; G8_SCHED;
            STB(g2, 0, 1, k2);
            G8_WAIT_V(6); G8_BAR; MMA(1, 1, At, B1); G8_BAR;
            LDB(B0, 1, 0); G8_SCHED; LDA(At, 1, 0); STA(g2, 0, 1, k2);
            G8_WAIT_L(8); G8_BAR; G8_WAIT_L(0); MMA(0, 0, At, B0); G8_BAR; G8_SCHED;
            LDB(B1, 1, 1); STB(g2, 1, 0, k3);
            G8_BAR; G8_WAIT_L(0); MMA(0, 1, At, B1); G8_BAR;
            LDA(At, 1, 1); STA(g2, 1, 0, k3);
            G8_BAR; G8_WAIT_L(0); MMA(1, 0, At, B0); G8_BAR; G8_SCHED;
            STB(g2, 1, 1, k3);
            G8_WAIT_V(6); G8_BAR; MMA(1, 1, At, B1); G8_BAR;
        }
        { int lane2; asm volatile("v_mbcnt_lo_u32_b32 %0, -1, 0\n\tv_mbcnt_hi_u32_b32 %0, -1, %0" : "=v"(lane2));
          pb.epi(cur)(acc, wid >> 2, wid & 3, lane2 & 15, lane2 >> 4, lds); }
        if (!has_next) break;
        ZERO_ACC();
        cur = nxt; gc = gn;
    }
    G8_WAIT_V(0);
    if (wr == 0) G8_BAR;
    G8_BAR;
#undef SA
#undef SB
#undef STAGE
#undef STA
#undef STB
#undef LDA
#undef LDB
#undef MMA
#undef ZERO_ACC
}

template <bool GATHER, class Prob>
__device__ __forceinline__ void gemm_units(LAS unsigned char* lds, int wave_s, int lane_v, const Prob& pb) {
    Unit u;
    for (int i = 0; pb.next(i, u); ++i) { GemmIn gi; pb.setup(u, gi); gemm_unit<GATHER>(lds, wave_s, lane_v, gi, pb.epi(u)); }
}
template <bool GATHER, class Prob>
__device__ __forceinline__ void gemm_units_dyn(LAS unsigned char* lds, int wave_s, int lane_v, const Prob& pb, unsigned* counter, int nM, int nN) {
    volatile LAS int* slot = (volatile LAS int*)(lds + LDS_MISC + 64);
    const int total = nM * nN;
    for (;;) {
        if (wave_s == 0 && lane_v == 0) *slot = (int)__hip_atomic_fetch_add(counter, 1u, __ATOMIC_RELAXED, __HIP_MEMORY_SCOPE_AGENT);
        __syncthreads();
        const int k = *slot;
        __syncthreads();
        if (k >= total) break;
        Unit u; u.pm = k / nN; u.pn = k - u.pm * nN;
        GemmIn gi; pb.setup(u, gi); gemm_unit<GATHER>(lds, wave_s, lane_v, gi, pb.epi(u));
    }
}
__device__ __forceinline__ void stage_coords(int tid, int& R0, int& R1, int& C) { int c1; stage_rc(tid * 16, R0, C); stage_rc(tid * 16 + 8192, R1, c1); }
__device__ __forceinline__ void stage_coords_now(int wave, int& R0, int& R1, int& C) {
    int ln; asm volatile("v_mbcnt_lo_u32_b32 %0, -1, 0\n\tv_mbcnt_hi_u32_b32 %0, -1, %0" : "=v"(ln));
    stage_coords(wave * 64 + ln, R0, R1, C);
}
__device__ __forceinline__ void set_A_rows(GemmIn& gi, const bf16_t* A, int row0, int lda, int R0, int R1, int C) {
    gi.rA = G8_RSRC(A); gi.sA = (unsigned)row0 * (unsigned)lda * 2u; gi.hstepA = 128u * (unsigned)lda * 2u;
    gi.va[0] = (unsigned)(R0 * lda + C) * 2u; gi.va[1] = (unsigned)(R1 * lda + C) * 2u;
    gi.vg[0][0] = gi.va[0]; gi.vg[0][1] = gi.va[1]; gi.vg[1][0] = gi.va[0]; gi.vg[1][1] = gi.va[1];
}
__device__ __forceinline__ void set_B(GemmIn& gi, const bf16_t* B0, const bf16_t* B1, unsigned row0_0, unsigned row0_1, int ksplit, int ldb, int R0, int R1, int C) {
    gi.rB0 = G8_RSRC(B0); gi.rB1 = G8_RSRC(B1); gi.sB0 = row0_0 * (unsigned)ldb * 2u; gi.sB1 = row0_1 * (unsigned)ldb * 2u; gi.ksplit = ksplit; gi.hstepB = 128u * (unsigned)ldb * 2u;
    gi.vb[0] = (unsigned)(R0 * ldb + C) * 2u; gi.vb[1] = (unsigned)(R1 * ldb + C) * 2u;
}
constexpr int EP_PB = 528, EP_PH = 272, EP_PF = 1040;
template <int PARTS> struct EpiScaleBf16 {
    static constexpr bool REPEATABLE = true;
    bf16_t* O; int ld, ncols; const float* rstd; int row0, col0; bool nt;
    __device__ __forceinline__ void pre_load(int t, float (&v)[4]) const { const int row = row0 + (t & 255);
        if (PARTS == 1) { v[0] = rstd[row]; v[1] = v[2] = v[3] = 0.f; }
        else { v[0] = rstd[row]; v[1] = rstd[(size_t)NT + row]; v[2] = rstd[(size_t)2 * NT + row]; v[3] = rstd[(size_t)3 * NT + row]; } }
    __device__ __forceinline__ void pre_commit(LAS unsigned char* lds, int t, const float (&v)[4]) const {
        if (t < 256) *(LAS float*)(lds + LDS_RPB + t * 4) = PARTS == 1 ? v[0] : rsqrtf(((v[0] + v[1]) + (v[2] + v[3])) * (1.0f / DM) + 1e-6f); }
    __device__ __forceinline__ void operator()(const f32x4 (&acc)[2][2][4][2], int wr, int wc, int fr, int fq, LAS unsigned char* lds) const {
        float rs[2][4];
#pragma unroll
        for (int ai = 0; ai < 2; ++ai)
#pragma unroll
            for (int m = 0; m < 4; ++m) rs[ai][m] = *(const LAS float*)(lds + LDS_RPB + (ai * HALF + wr * 64 + m * 16 + fr) * 4);
        const int t = (wr * 4 + wc) * 64 + fq * 16 + fr;
#pragma unroll
        for (int ai = 0; ai < 2; ++ai)
#pragma unroll
            for (int m = 0; m < 4; ++m)
#pragma unroll
                for (int bj = 0; bj < 2; ++bj)
#pragma unroll
                    for (int n = 0; n < 2; ++n) { const f32x4 v = acc[ai][bj][m][n] * rs[ai][m]; u32x2 w; w.x = pk2(v[0], v[1]); w.y = pk2(v[2], v[3]);
                        *(LAS u32x2*)(lds + (ai * HALF + wr * 64 + m * 16 + fr) * EP_PB + (bj * HALF + wc * 32 + n * 16 + 4 * fq) * 2) = w; }
        __syncthreads();
#pragma unroll
        for (int p = 0; p < 16; ++p) { const int rl = p * 16 + (t >> 5), ch = t & 31, col = col0 + ch * 8;
            if (col < ncols) { const u32x4 w4 = *(const LAS u32x4*)(lds + rl * EP_PB + ch * 16); u32x4* dp = (u32x4*)(O + (size_t)(row0 + rl) * ld + col);
                if (nt) __builtin_nontemporal_store(w4, dp); else *dp = w4; } }
        __syncthreads();
    }
};
struct EpiGateUp {
    static constexpr bool REPEATABLE = true;
    bf16_t* H; const float* rstds; const float* wsel; int row0, colh0;
    __device__ __forceinline__ void pre_load(int t, float (&v)[4]) const { v[0] = rstds[row0 + (t & 255)]; v[1] = wsel[row0 + (t & 255)]; v[2] = v[3] = 0.f; }
    __device__ __forceinline__ void pre_commit(LAS unsigned char* lds, int t, const float (&v)[4]) const { if (t < 256) { *(LAS float*)(lds + LDS_RPB + t * 4) = v[0]; *(LAS float*)(lds + LDS_RPB + 1024 + t * 4) = v[1]; } }
    __device__ __forceinline__ void operator()(const f32x4 (&acc)[2][2][4][2], int wr, int wc, int fr, int fq, LAS unsigned char* lds) const {
        const int t = (wr * 4 + wc) * 64 + fq * 16 + fr;
#pragma unroll
        for (int ai = 0; ai < 2; ++ai)
#pragma unroll
            for (int m = 0; m < 4; ++m) {
                const int rl = ai * HALF + wr * 64 + m * 16 + fr; const float rs = *(const LAS float*)(lds + LDS_RPB + rl * 4), w = *(const LAS float*)(lds + LDS_RPB + 1024 + rl * 4);
#pragma unroll
                for (int n = 0; n < 2; ++n) { f32x4 o;
#pragma unroll
                    for (int j = 0; j < 4; ++j) { const float g = acc[ai][0][m][n][j] * rs, u = acc[ai][1][m][n][j] * rs; o[j] = g * __builtin_amdgcn_rcpf(1.0f + __expf(-g)) * u * w; }
                    u32x2 pw; pw.x = pk2(o[0], o[1]); pw.y = pk2(o[2], o[3]); *(LAS u32x2*)(lds + rl * EP_PH + (wc * 32 + n * 16 + 4 * fq) * 2) = pw; }
            }
        __syncthreads();
#pragma unroll
        for (int p = 0; p < 8; ++p) { const int rl = p * 32 + (t >> 4), ch = t & 15;
            *(u32x4*)(H + (size_t)(row0 + rl) * DM + colh0 + ch * 8) = *(const LAS u32x4*)(lds + rl * EP_PH + ch * 16); }
        __syncthreads();
    }
};
template <bool SCATTER, bool F32OUT> struct EpiResidT {
    static constexpr bool REPEATABLE = false;
    __device__ __forceinline__ void pre_load(int t, float (&v)[4]) const { v[0] = SCATTER ? __int_as_float(tokpos[row0 + (t & 255)]) : 0.f; v[1] = v[2] = v[3] = 0.f; }
    __device__ __forceinline__ void pre_commit(LAS unsigned char* lds, int t, const float (&v)[4]) const { if (SCATTER && t < 256) *(LAS float*)(lds + LDS_RPB + t * 4) = v[0]; }
    const bf16_t* xres; float* out; bf16_t* xo; const int* tokpos; float* ssq; int row0, col0;
    __device__ __forceinline__ void operator()(const f32x4 (&acc)[2][2][4][2], int wr, int wc, int fr, int fq, LAS unsigned char* lds) const {
        const int t = (wr * 4 + wc) * 64 + fq * 16 + fr, ch = t & 31, tr = t >> 5;
#pragma unroll
        for (int hq = 0; hq < 2; ++hq) {
            int rows[8]; u32x4 rw[8];
#pragma unroll
            for (int k = 0; k < 8; ++k) { const int rl = hq * HALF + (k >> 2) * 64 + (k & 3) * 16 + tr; rows[k] = SCATTER ? *(const LAS int*)(lds + LDS_RPB + rl * 4) : row0 + rl; }
#pragma unroll
            for (int k = 0; k < 8; ++k) rw[k] = *(const u32x4*)(xres + (size_t)(rows[k] < 0 ? 0 : rows[k]) * DM + col0 + ch * 8);
#pragma unroll
            for (int m = 0; m < 4; ++m)
#pragma unroll
                for (int bj = 0; bj < 2; ++bj)
#pragma unroll
                    for (int n = 0; n < 2; ++n) *(LAS f32x4*)(lds + (wr * 64 + m * 16 + fr) * EP_PF + (bj * HALF + wc * 32 + n * 16 + 4 * fq) * 4) = acc[hq][bj][m][n];
            __syncthreads();
#pragma unroll
            for (int p = 0; p < 8; ++p) { const int rl = p * 16 + tr, row = rows[p];
                if (!SCATTER || row >= 0) { const size_t o = (size_t)row * DM + col0 + ch * 8;
                    float r8[8]; unpack8(rw[p], r8);
                    const f32x4 a0 = *(const LAS f32x4*)(lds + rl * EP_PF + ch * 32), a1 = *(const LAS f32x4*)(lds + rl * EP_PF + ch * 32 + 16);
                    const f32x4 v0 = (f32x4){r8[0], r8[1], r8[2], r8[3]} + a0, v1 = (f32x4){r8[4], r8[5], r8[6], r8[7]} + a1;
                    if (F32OUT) { __builtin_nontemporal_store(v0, (f32x4*)(out + o)); __builtin_nontemporal_store(v1, (f32x4*)(out + o + 4)); }
                    else { u32x4 w; w.x = pk2(v0[0], v0[1]); w.y = pk2(v0[2], v0[3]); w.z = pk2(v1[0], v1[1]); w.w = pk2(v1[2], v1[3]); *(u32x4*)(xo + o) = w;
                        if (ssq) { float s2 = ((v0[0] * v0[0] + v0[1] * v0[1]) + (v0[2] * v0[2] + v0[3] * v0[3])) + ((v1[0] * v1[0] + v1[1] * v1[1]) + (v1[2] * v1[2] + v1[3] * v1[3]));
#pragma unroll
                            for (int sh = 16; sh >= 1; sh >>= 1) s2 += __shfl_xor(s2, sh);
                            if (ch == 0) ssq[(size_t)(col0 >> 8) * NT + row] = s2; } } } }
            __syncthreads();
        }
    }
};
typedef EpiResidT<false, false> EpiResid;
}

#define WSP(T, off) ((T*)(F.ws + (off)))
#define RWBUF(i) ((bf16_t*)(F.ws + WS_RW + (size_t)((i) == 3 ? 0 : ((i) == 8 ? 1 : 2)) * RWB))

struct TJob { const float* src; int sld; bf16_t* dst; int dld; const float* scale; };
struct TRaw { f32x4 v0, v1; float s0, s1; };
__device__ __forceinline__ void tjob_fetch(const TJob& jb, int tid, TRaw& r) {
    const int kk = tid >> 4, c4 = (tid & 15) * 4;
    r.v0 = __builtin_nontemporal_load((const f32x4*)(jb.src + (size_t)kk * jb.sld + c4)); r.v1 = __builtin_nontemporal_load((const f32x4*)(jb.src + (size_t)(kk + 32) * jb.sld + c4));
    r.s0 = jb.scale ? jb.scale[kk] : 1.0f; r.s1 = jb.scale ? jb.scale[kk + 32] : 1.0f;
}
__device__ __forceinline__ void tjob_to_lds(LAS float* T, int tid, const TRaw& r) {
    const int kk = tid >> 4, c4 = (tid & 15) * 4;
#pragma unroll
    for (int e = 0; e < 4; ++e) { T[kk * 65 + c4 + e] = r.v0[e] * r.s0; T[(kk + 32) * 65 + c4 + e] = r.v1[e] * r.s1; }
}
__device__ __forceinline__ void row_prep(const float* src, bf16_t* dstb, float* rstd, int row, int lane, bool as_rstd) {
    const f32x4* s = (const f32x4*)(src + (size_t)row * DM); u32x2* d = (u32x2*)(dstb + (size_t)row * DM); float ss = 0.f;
#pragma unroll
    for (int i = 0; i < 4; ++i) { const f32x4 v = __builtin_nontemporal_load(s + i * 64 + lane); ss += v[0] * v[0] + v[1] * v[1] + v[2] * v[2] + v[3] * v[3]; u32x2 w; w.x = pk2(v[0], v[1]); w.y = pk2(v[2], v[3]); d[i * 64 + lane] = w; }
    ss = wave_sum(ss);
    if (lane == 0) rstd[row] = as_rstd ? rsqrtf(ss * (1.0f / DM) + 1e-6f) : ss;
}
__device__ __forceinline__ void weight_prep(Frame& F, int l, int b0, int nb, int part) {
    const int vb = (int)launder_uniform((uintptr_t)(unsigned)(F.bid - b0));
    bf16_t* WB = WSP(bf16_t, WS_W + (size_t)l * W_STRIDE);
    bf16_t* WinT = WB + W_IN / 2; bf16_t* WmemT = WB + W_MEM / 2; bf16_t* WoutT = WB + W_OUT / 2; bf16_t* WguT = WB + W_GU / 2; bf16_t* WdT = WB + W_DN / 2;
    const float* w_in = F.in[3] + (size_t)l * DM * PIN; const float* attn_nw = F.in[2] + l * DM;
    const float* w_mem = F.in[20] + (size_t)l * DM * 512; const float* mem_nw = F.in[19] + l * DM;
    const float* w_out = F.in[23] + (size_t)l * DM * DM; const float* ffn_nw = F.in[24] + l * DM;
    const float* w_gate = F.in[29] + (size_t)l * 16 * DM * 512; const float* w_up = F.in[30] + (size_t)l * 16 * DM * 512; const float* w_down = F.in[31] + (size_t)l * 16 * 512 * DM;
    constexpr int NJ = 736 + 128 + 256 + 4096 + 2048;
#define TDECODE(jx, J) do { int j = (jx); \
        if (j < 736) { const int kt = j & 15, ntl = j >> 4, ntd = ntl < SRC_RW / 64 ? ntl : (ntl < SRC_MQ / 64 ? ntl + 4 : ntl - 18);       \
            J.src = w_in + (size_t)kt * 64 * PIN + ntl * 64; J.sld = PIN; J.dst = WinT + (size_t)ntd * 64 * DM + kt * 64; J.dld = DM; J.scale = attn_nw + kt * 64; } \
        else if (j < 864) { j -= 736; const int kt = j & 15, ntl = j >> 4; J.src = w_mem + (size_t)kt * 64 * 512 + ntl * 64; J.sld = 512; J.dst = WmemT + (size_t)ntl * 64 * DM + kt * 64; J.dld = DM; J.scale = mem_nw + kt * 64; } \
        else if (j < 1120) { j -= 864; const int kt = j & 15, ntl = j >> 4; J.src = w_out + (size_t)kt * 64 * DM + ntl * 64; J.sld = DM; J.dst = WoutT + (size_t)ntl * 64 * DM + kt * 64; J.dld = DM; J.scale = nullptr; } \
        else if (j < 5216) { j -= 1120; const int kt = j & 15, ntl = (j >> 4) & 7, gu = (j >> 7) & 1, e = j >> 8; \
            J.src = (gu ? w_up : w_gate) + (size_t)e * DM * 512 + (size_t)kt * 64 * 512 + ntl * 64; J.sld = 512; \
            J.dst = WguT + ((size_t)e * 1024 + (ntl >> 1) * 256 + gu * 128 + (ntl & 1) * 64) * DM + kt * 64; J.dld = DM; J.scale = ffn_nw + kt * 64; } \
        else { j -= 5216; const int kt = j & 7, ntl = (j >> 3) & 15, e = j >> 7; \
            J.src = w_down + (size_t)e * 512 * DM + (size_t)kt * 64 * DM + ntl * 64; J.sld = DM; J.dst = WdT + ((size_t)e * 1024 + ntl * 64) * 512 + kt * 64; J.dld = 512; J.scale = nullptr; } } while (0)
    const int NJp = part == 0 ? NJ : (part == 1 ? 128 : NJ - 128);
#define JMAP(k) (part == 0 ? (k) : (part == 1 ? 736 + (k) : ((k) < 736 ? (k) : (k) + 128)))
    if (vb < NJp) {
        LAS float* T = (LAS float*)F.lds;
        TJob cur; TDECODE(JMAP(vb), cur); TRaw raw; tjob_fetch(cur, F.tid, raw);
        for (int jb = vb; jb < NJp; jb += nb) {
            tjob_to_lds(T, F.tid, raw);
            __syncthreads();
            bf16_t* const cdst = cur.dst; const int cdld = cur.dld;
            const int jn = jb + nb;
            if (jn < NJp) { TDECODE(JMAP(jn), cur); tjob_fetch(cur, F.tid, raw); }
            { const int n = F.tid >> 3, k8 = (F.tid & 7) * 8; float f[8];
#pragma unroll
              for (int e = 0; e < 8; ++e) f[e] = T[(k8 + e) * 65 + n];
              *(bf16x8*)(cdst + (size_t)n * cdld + k8) = pack8(f); }
            __syncthreads();
        }
    }
#undef TDECODE
#undef JMAP
    if (part == 2) return;
    { unsigned z = 0u; asm volatile("" : "+v"(z));
      for (int i = vb * NTHREADS + F.tid; i < 128 * DM / 8; i += nb * NTHREADS) ((u32x4*)(WinT + (size_t)PIN * DM))[i] = (u32x4){z, z, z, z}; }
    { unsigned char* WI = F.ws + WS_WR2 + (size_t)l * WR_STRIDE; const float* wg = F.in[25] + (size_t)l * DM * 4; const float* we = F.in[27] + (size_t)l * DM * 16;
      for (int i = vb * NTHREADS + F.tid; i < 2 * 32 * 64; i += nb * NTHREADS) { const int ln = i & 63, ks = (i >> 6) & 31, nt = i >> 11, o = nt * 16 + (ln & 15), k0 = ks * 32 + 8 * (ln >> 4);
          float v[8], r[8];
#pragma unroll
          for (int e = 0; e < 8; ++e) { const int k = k0 + e; v[e] = o < 4 ? wg[k * 4 + o] * ffn_nw[k] : (o < 20 ? we[k * 16 + (o - 4)] * ffn_nw[k] : 0.f); }
          const u32x4 w = __builtin_bit_cast(u32x4, pack8(v)); unpack8(w, r);
#pragma unroll
          for (int e = 0; e < 8; ++e) r[e] = v[e] - r[e];
          *(u32x4*)(WI + (size_t)i * 16) = w; *(u32x4*)(WI + 65536 + (size_t)i * 16) = __builtin_bit_cast(u32x4, pack8(r)); }
      if (vb == 0 && F.tid < 32) ((float*)(WI + 131072))[F.tid] = F.tid < 4 ? F.in[26][l * 4 + F.tid] : (F.tid < 20 ? F.in[28][l * 16 + F.tid - 4] : 0.f); }
    { bf16_t* W2T = WSP(bf16_t, WS_LORA + (size_t)l * LORA_STRIDE); bf16_t* A2T = W2T + 2 * 256 * 64; bf16_t* G2T = A2T + 2 * 256 * 64;
      const float* w2 = F.in[10] + (size_t)l * 2 * 64 * 256; const float* a2 = F.in[12] + (size_t)l * 2 * 64 * 256; const float* g2 = F.in[13] + (size_t)l * 128 * 256;
      for (int i = vb * NTHREADS + F.tid; i < 2 * 256 * 64; i += nb * NTHREADS) { const int j = i & 63, c = (i >> 6) & 255, d = i >> 14; W2T[i] = f2bf(w2[(size_t)(d * 64 + j) * 256 + c]); A2T[i] = f2bf(a2[(size_t)(d * 64 + j) * 256 + c]); }
      for (int i = vb * NTHREADS + F.tid; i < 256 * 128; i += nb * NTHREADS) { const int j = i & 127, c = i >> 7; G2T[i] = f2bf(g2[(size_t)j * 256 + c]); } }
}
constexpr int WPA_UNITS = 64, WPB_UNITS = 1408;
__device__ __forceinline__ void wp_tail(Frame& F, int maxu) {
    unsigned* ctr = (unsigned*)(F.ws + WS_CTL + 512 * KiB) + 160;
    volatile LAS int* qs = (volatile LAS int*)(F.lds + LDS_MISC + 64);
#pragma unroll 1
    for (int k = 0; k < maxu; ++k) {
        refresh(F);
        __syncthreads();
        if (F.tid == 0) *qs = (int)__hip_atomic_fetch_add(ctr, 1u, __ATOMIC_RELAXED, __HIP_MEMORY_SCOPE_AGENT);
        __syncthreads();
        const int u = __builtin_amdgcn_readfirstlane(*qs);
        if (u >= WPB_UNITS) break;
        weight_prep(F, 1, F.bid - u, WPB_UNITS, 2);
    }
    __syncthreads();
}
__device__ __forceinline__ void phase_prep(Frame& F, int l) {
    weight_prep(F, 0, 0, GRID, 0);
    float* ssq = WSP(float, WS_SSQ);
    for (int row = F.bid * NWAVES + F.wave; row < NT; row += GRID * NWAVES) { row_prep(F.in[0], (bf16_t*)((char*)F.out + DO_XB), ssq, row, F.lane, false); if (F.lane < 3) ssq[(size_t)(1 + F.lane) * NT + row] = 0.f; }
    for (int row = F.bid * NWAVES + F.wave; row < NMROWS; row += GRID * NWAVES) row_prep(F.in[1], WSP(bf16_t, WS_MEMB), WSP(float, WS_RSTDM), row, F.lane, true);
}

template <int PARTS> struct ProbInproj {
    g8::StaticOrder S; int wave; const bf16_t* A; const bf16_t* Bt; bf16_t* O; bf16_t* O2; const float* rstd; int ld, ncols;
    __device__ __forceinline__ bool next(int i, g8::Unit& u) const { return S.next(i, u); }
    __device__ __forceinline__ void setup(const g8::Unit& u, g8::GemmIn& gi) const { int R0, R1, C; g8::stage_coords_now(wave, R0, R1, C); g8::set_A_rows(gi, A, u.pm * 256, DM, R0, R1, C); g8::set_B(gi, Bt, Bt, u.pn * 256, u.pn * 256, 16, DM, R0, R1, C); }
    __device__ __forceinline__ g8::EpiScaleBf16<PARTS> epi(const g8::Unit& u) const { return (O2 && u.pn >= 7) ? g8::EpiScaleBf16<PARTS>{O2, PR_LD, PR_LD, rstd, u.pm * 256, (u.pn - 7) * 256, false} : g8::EpiScaleBf16<PARTS>{O, ld, ncols, rstd, u.pm * 256, u.pn * 256, O2 != nullptr}; }
};
__device__ __forceinline__ void memkv_gemm(Frame& F, int l, int vb);
__device__ __forceinline__ void phase_inproj(Frame& F, int l) {
    bf16_t* WB = WSP(bf16_t, WS_W + (size_t)l * W_STRIDE);
    { ProbInproj<4> pb; pb.S.init(NT / 256, PINP / 256, GRID, F.bid); pb.wave = F.wave; pb.A = (const bf16_t*)((const char*)F.out + DO_XB); pb.Bt = WB + W_IN / 2; pb.O = WSP(bf16_t, WS_PA); pb.O2 = WSP(bf16_t, WS_PR); pb.rstd = WSP(float, WS_SSQ); pb.ld = PA_LD; pb.ncols = PA_LD;
#if DYN_GEMM
      g8::gemm_units_dyn<false>(F.lds, F.wave, F.lane, pb, (unsigned*)(F.ws + WS_CTL + 64 * KiB) + (l * 8 + 0) * 64, NT / 256, PINP / 256); }
#else
      g8::gemm_units<false>(F.lds, F.wave, F.lane, pb); }
#endif
}
__device__ __forceinline__ void memkv_gemm(Frame& F, int l, int vb) {
    bf16_t* WB = WSP(bf16_t, WS_W + (size_t)l * W_STRIDE);
    { ProbInproj<1> pb; pb.S.init(NMROWS / 256, 2, GRID, vb); pb.wave = F.wave; pb.A = WSP(bf16_t, WS_MEMB); pb.Bt = WB + W_MEM / 2; pb.O = WSP(bf16_t, WS_MEMKV); pb.O2 = nullptr; pb.rstd = WSP(float, WS_RSTDM); pb.ld = 512; pb.ncols = 512;
      g8::gemm_units<false>(F.lds, F.wave, F.lane, pb); }
}

constexpr int RL_MUP = 0, RL_MUN = 1152, RL_W0 = 2304, RL_A0 = 2816, RL_KK = 3328, RL_KA = 3584, RL_RK = 3840, RL_N = 4096;
struct Sh8Raw { u32x4 c, p, n; };
__device__ __forceinline__ void rw_load8(const char* P, unsigned rowb, int t, int col, Sh8Raw& r) {
    const unsigned off = rowb + (unsigned)col * 2u;
    r.c = *(const u32x4*)(P + off); r.p = *(const u32x4*)(P + (t > 0 ? off - PR_LD * 2 : off)); r.n = *(const u32x4*)(P + (t < SEQ - 1 ? off + PR_LD * 2 : off));
}
__device__ __forceinline__ void rw_shift8(const Sh8Raw& r, int t, int col, const LAS float* cst, float (&o)[8]) {
    const bool hp = t > 0, hn = t < SEQ - 1;
    const u32x4 pz = (u32x4){hp ? r.p.x : 0u, hp ? r.p.y : 0u, hp ? r.p.z : 0u, hp ? r.p.w : 0u}, nz = (u32x4){hn ? r.n.x : 0u, hn ? r.n.y : 0u, hn ? r.n.z : 0u, hn ? r.n.w : 0u};
    float c[8], pr[8], nx[8]; unpack8(r.c, c); unpack8(pz, pr); unpack8(nz, nx);
    const f32x4 m0 = *(const LAS f32x4*)(cst + RL_MUP + col), m1 = *(const LAS f32x4*)(cst + RL_MUP + col + 4), n0 = *(const LAS f32x4*)(cst + RL_MUN + col), n1 = *(const LAS f32x4*)(cst + RL_MUN + col + 4);
#pragma unroll
    for (int e = 0; e < 4; ++e) { o[e] = c[e] + m0[e] * (pr[e] - c[e]) + n0[e] * (nx[e] - c[e]); o[4 + e] = c[4 + e] + m1[e] * (pr[4 + e] - c[4 + e]) + n1[e] * (nx[4 + e] - c[4 + e]); }
}
struct Sh4Raw { u32x2 c, p, n; };
__device__ __forceinline__ void rw_load4(const char* P, unsigned rowb, int t, int col, Sh4Raw& r) {
    const unsigned off = rowb + (unsigned)col * 2u;
    r.c = *(const u32x2*)(P + off); r.p = *(const u32x2*)(P + (t > 0 ? off - PR_LD * 2 : off)); r.n = *(const u32x2*)(P + (t < SEQ - 1 ? off + PR_LD * 2 : off));
}
__device__ __forceinline__ f32x4 rw_shift4(const Sh4Raw& r, int t, int col, const LAS float* cst) {
    const bool hp = t > 0, hn = t < SEQ - 1;
    const u32x2 pv = (u32x2){hp ? r.p.x : 0u, hp ? r.p.y : 0u}, nv = (u32x2){hn ? r.n.x : 0u, hn ? r.n.y : 0u};
    const f32x4 c = (f32x4){bflo(r.c.x), bfhi(r.c.x), bflo(r.c.y), bfhi(r.c.y)}, pr = (f32x4){bflo(pv.x), bfhi(pv.x), bflo(pv.y), bfhi(pv.y)}, nx = (f32x4){bflo(nv.x), bfhi(nv.x), bflo(nv.y), bfhi(nv.y)};
    return c + *(const LAS f32x4*)(cst + RL_MUP + col) * (pr - c) + *(const LAS f32x4*)(cst + RL_MUN + col) * (nx - c);
}
#ifndef RWP_VAR
#define RWP_VAR 0
#endif
__device__ __forceinline__ void st4bf(char* base, unsigned off, const f32x4 v) { u32x2 w; w.x = pk2(v[0], v[1]); w.y = pk2(v[2], v[3]); *(u32x2*)(base + off) = w; }
__device__ __forceinline__ u32x2 pk4(const f32x4 v) { u32x2 w; w.x = pk2(v[0], v[1]); w.y = pk2(v[2], v[3]); return w; }
#define ST4W(base, off, w) do { if (RWP_VAR == 1 && F.dup) { dmy ^= (w).x ^ (w).y; } else *(u32x2*)((base) + (off)) = (w); } while (0)
#define ST4BF(base, off, v) do { if (RWP_VAR == 1 && F.dup) { const f32x4 v_ = (v); dmy ^= pk2(v_[0], v_[1]) ^ pk2(v_[2], v_[3]); } else st4bf(base, off, v); } while (0)

constexpr int KVS = 68;
__device__ __forceinline__ void load_row64(const bf16_t* src, float (&f)[64]) {
    const u32x4* s = (const u32x4*)src;
#pragma unroll
    for (int i = 0; i < 8; ++i) { const u32x4 v = s[i];
        f[i * 8 + 0] = bflo(v.x); f[i * 8 + 1] = bfhi(v.x); f[i * 8 + 2] = bflo(v.y); f[i * 8 + 3] = bfhi(v.y);
        f[i * 8 + 4] = bflo(v.z); f[i * 8 + 5] = bfhi(v.z); f[i * 8 + 6] = bflo(v.w); f[i * 8 + 7] = bfhi(v.w); }
}
__device__ __forceinline__ void norm_row64(float (&f)[64], const float* w, float extra) {
    float ss = 0.f;
#pragma unroll
    for (int d = 0; d < 64; ++d) ss += f[d] * f[d];
    const float rs = rsqrtf(ss * (1.0f / 64.0f) + 1e-6f) * extra;
#pragma unroll
    for (int d = 0; d < 64; ++d) f[d] = f[d] * rs * w[d];
}
typedef __bf16 bf16x2_t __attribute__((ext_vector_type(2)));
__device__ __forceinline__ void pack_row64(const float (&f)[64], unsigned (&p)[32]) {
#pragma unroll
    for (int i = 0; i < 32; ++i) p[i] = pk2(f[2 * i], f[2 * i + 1]);
}
__device__ __forceinline__ void store_row64_lds(LAS bf16_t* dst, const float (&f)[64]) {
#pragma unroll
    for (int i = 0; i < 16; ++i) { u32x2 w; w.x = pk2(f[i * 4], f[i * 4 + 1]); w.y = pk2(f[i * 4 + 2], f[i * 4 + 3]); *(LAS u32x2*)(dst + i * 4) = w; }
}
__device__ __forceinline__ float dot_row64_lds(const LAS bf16_t* krow, const unsigned (&q)[32]) {
    float s0 = 0.f, s1 = 0.f;
#pragma unroll
    for (int i = 0; i < 16; ++i) { const u32x2 w = *(const LAS u32x2*)(krow + i * 4);
        s0 = __builtin_amdgcn_fdot2_f32_bf16(__builtin_bit_cast(bf16x2_t, q[2 * i]), __builtin_bit_cast(bf16x2_t, w.x), s0, false);
        s1 = __builtin_amdgcn_fdot2_f32_bf16(__builtin_bit_cast(bf16x2_t, q[2 * i + 1]), __builtin_bit_cast(bf16x2_t, w.y), s1, false); }
    return s0 + s1;
}

typedef short s16x4 __attribute__((ext_vector_type(4)));
constexpr int VST_PITCH = 144;
__device__ __forceinline__ void norm_frag(const u32x4 r0, const u32x4 r1, const float (&wv)[16], float extra, bf16x8 (&fr)[2]) {
    float f[16]; unpack8(r0, f); unpack8(r1, f + 8);
    float ss = 0.f;
#pragma unroll
    for (int e = 0; e < 16; ++e) ss += f[e] * f[e];
    ss += __shfl_xor(ss, 16); ss += __shfl_xor(ss, 32);
    const float rs = rsqrtf(ss * (1.0f / 64.0f) + 1e-6f) * extra;
#pragma unroll
    for (int e = 0; e < 16; ++e) f[e] = f[e] * rs * wv[e];
    fr[0] = pack8(f); fr[1] = pack8(f + 8);
}
__device__ __forceinline__ void load_norm_frag(const bf16_t* rowp, int g, const float (&wv)[16], float extra, bf16x8 (&fr)[2]) {
    float f[16]; unpack8(*(const u32x4*)(rowp + 8 * g), f); unpack8(*(const u32x4*)(rowp + 32 + 8 * g), f + 8);
    float ss = 0.f;
#pragma unroll
    for (int e = 0; e < 16; ++e) ss += f[e] * f[e];
    ss += __shfl_xor(ss, 16); ss += __shfl_xor(ss, 32);
    const float rs = rsqrtf(ss * (1.0f / 64.0f) + 1e-6f) * extra;
#pragma unroll
    for (int e = 0; e < 16; ++e) f[e] = f[e] * rs * wv[e];
    fr[0] = pack8(f); fr[1] = pack8(f + 8);
}
template <bool NA>
__device__ __forceinline__ void attn_wave_unit(int lane, LAS unsigned char* vst, const bf16_t* qrow0, const float (&wqv)[16], const float (&wkv)[16],
                                               const bf16_t* kbase, size_t nstep, size_t istep, int voff, bf16_t* out0,
                                               const float* rpb_h, int r, int rs, int cb, int q0) {
    const int c16 = lane & 15, g = lane >> 4;
    bf16x8 qf[2]; load_norm_frag(qrow0 + (size_t)c16 * PA_LD, g, wqv, 0.125f, qf);
    float s[16][4];
    const int qc = q0 + c16, cs = min(max(qc - 8, 0), 48);
#pragma unroll
    for (int t = 0; t < 16; ++t) {
        const int n = t >> 1, half = t & 1;
        bf16x8 kf[2]; load_norm_frag(kbase + (size_t)n * nstep + (size_t)(half * 16 + c16) * istep, g, wkv, 1.0f, kf);
        f32x4 acc = (f32x4){0.f, 0.f, 0.f, 0.f};
        acc = __builtin_amdgcn_mfma_f32_16x16x32_bf16(kf[0], qf[0], acc, 0, 0, 0);
        acc = __builtin_amdgcn_mfma_f32_16x16x32_bf16(kf[1], qf[1], acc, 0, 0, 0);
#pragma unroll
        for (int j = 0; j < 4; ++j) {
            if (NA) { const int kc = cb + half * 16 + 4 * g + j; const bool ok = (kc >= cs) && (kc < cs + 16);
                s[t][j] = ok ? acc[j] + rpb_h[(rs + n - r + 7) * 31 + (ok ? kc - qc + 15 : 0)] : -1e30f; }
            else s[t][j] = acc[j];
        }
    }
    float m = -1e30f;
#pragma unroll
    for (int t = 0; t < 16; ++t)
#pragma unroll
        for (int j = 0; j < 4; ++j) m = fmaxf(m, s[t][j]);
    m = fmaxf(m, __shfl_xor(m, 16)); m = fmaxf(m, __shfl_xor(m, 32));
    float ls = 0.f;
#pragma unroll
    for (int t = 0; t < 16; ++t)
#pragma unroll
        for (int j = 0; j < 4; ++j) { const float p = (NA && s[t][j] < -1e29f) ? 0.f : __expf(s[t][j] - m); s[t][j] = p; ls += p; }
    ls += __shfl_xor(ls, 16); ls += __shfl_xor(ls, 32);
    f32x4 o[4];
#pragma unroll
    for (int dt = 0; dt < 4; ++dt) o[dt] = (f32x4){0.f, 0.f, 0.f, 0.f};
    const int q4 = c16 >> 2, p4 = lane & 3;
    const int ki = lane >> 1, hf = lane & 1;
    const bf16_t* vsrc = kbase + voff + (size_t)ki * istep + hf * 32;
    u32x4 v0, v1, v2, v3;
    { const u32x4* src = (const u32x4*)vsrc; v0 = src[0]; v1 = src[1]; v2 = src[2]; v3 = src[3]; }
#pragma unroll
    for (int n = 0; n < 8; ++n) {
        LAS unsigned char* vb = vst + (n & 1) * (32 * VST_PITCH);
        { LAS u32x4* dst = (LAS u32x4*)(vb + ki * VST_PITCH + hf * 64); dst[0] = v0; dst[1] = v1; dst[2] = v2; dst[3] = v3; }
        if (n + 1 < 8) { const u32x4* src = (const u32x4*)(vsrc + (size_t)(n + 1) * nstep); v0 = src[0]; v1 = src[1]; v2 = src[2]; v3 = src[3]; }
        float pf[8] = {s[2 * n][0], s[2 * n][1], s[2 * n][2], s[2 * n][3], s[2 * n + 1][0], s[2 * n + 1][1], s[2 * n + 1][2], s[2 * n + 1][3]};
        const bf16x8 pb = pack8(pf);
#pragma unroll
        for (int dt = 0; dt < 4; ++dt) {
            const s16x4 va = __builtin_amdgcn_ds_read_tr16_b64_v4i16((LAS s16x4*)(vb + (4 * g + q4) * VST_PITCH + 32 * dt + 8 * p4));
            const s16x4 vb2 = __builtin_amdgcn_ds_read_tr16_b64_v4i16((LAS s16x4*)(vb + (16 + 4 * g + q4) * VST_PITCH + 32 * dt + 8 * p4));
            const bf16x8 vt = (bf16x8){va[0], va[1], va[2], va[3], vb2[0], vb2[1], vb2[2], vb2[3]};
            o[dt] = __builtin_amdgcn_mfma_f32_16x16x32_bf16(vt, pb, o[dt], 0, 0, 0);
        }
    }
    const float inv = __builtin_amdgcn_rcpf(ls);
    int l2; asm volatile("v_mbcnt_lo_u32_b32 %0, -1, 0\n\tv_mbcnt_hi_u32_b32 %0, -1, %0" : "=v"(l2));
    bf16_t* op = out0 + (unsigned)((l2 & 15) * DM + 4 * (l2 >> 4));
#pragma unroll
    for (int dt = 0; dt < 4; ++dt) { u32x2 w; w.x = pk2(o[dt][0] * inv, o[dt][1] * inv); w.y = pk2(o[dt][2] * inv, o[dt][3] * inv);
        *(u32x2*)(op + 16 * dt) = w; }
}
__device__ __forceinline__ void mem_wave_unit(int lane, const LAS unsigned char* kimg, const LAS unsigned char* vimg, const bf16_t* qrow0, const float (&wqv)[16], bf16_t* out0) {
    const int c16 = lane & 15, g = lane >> 4;
    bf16x8 qf[2]; load_norm_frag(qrow0 + (size_t)c16 * PA_LD, g, wqv, 0.125f * 1.44269504089f, qf);
    float s[16][4];
#pragma unroll
    for (int t = 0; t < 16; ++t) {
        if ((t & 3) == 0) __builtin_amdgcn_sched_barrier(0);
        const LAS unsigned char* kr = kimg + (16 * t + c16) * VST_PITCH + 16 * g;
        const bf16x8 k0 = *(const LAS bf16x8*)kr, k1 = *(const LAS bf16x8*)(kr + 64);
        f32x4 acc = (f32x4){0.f, 0.f, 0.f, 0.f};
        acc = __builtin_amdgcn_mfma_f32_16x16x32_bf16(k0, qf[0], acc, 0, 0, 0);
        acc = __builtin_amdgcn_mfma_f32_16x16x32_bf16(k1, qf[1], acc, 0, 0, 0);
#pragma unroll
        for (int j = 0; j < 4; ++j) s[t][j] = acc[j];
    }
    float m = -1e30f;
#pragma unroll
    for (int t = 0; t < 16; ++t)
#pragma unroll
        for (int j = 0; j < 4; ++j) m = fmaxf(m, s[t][j]);
    m = fmaxf(m, __shfl_xor(m, 16)); m = fmaxf(m, __shfl_xor(m, 32));
    float ls = 0.f;
#pragma unroll
    for (int t = 0; t < 16; ++t)
#pragma unroll
        for (int j = 0; j < 4; ++j) { const float p = __builtin_amdgcn_exp2f(s[t][j] - m); s[t][j] = p; ls += p; }
    ls += __shfl_xor(ls, 16); ls += __shfl_xor(ls, 32);
    f32x4 o[4];
#pragma unroll
    for (int dt = 0; dt < 4; ++dt) o[dt] = (f32x4){0.f, 0.f, 0.f, 0.f};
    const int q4 = c16 >> 2, p4 = lane & 3;
#pragma unroll
    for (int n = 0; n < 8; ++n) {
        float pf[8] = {s[2 * n][0], s[2 * n][1], s[2 * n][2], s[2 * n][3], s[2 * n + 1][0], s[2 * n + 1][1], s[2 * n + 1][2], s[2 * n + 1][3]};
        const bf16x8 pb = pack8(pf);
        const LAS unsigned char* vb = vimg + (32 * n) * VST_PITCH;
#pragma unroll
        for (int dt = 0; dt < 4; ++dt) {
            const s16x4 va = __builtin_amdgcn_ds_read_tr16_b64_v4i16((LAS s16x4*)(vb + (4 * g + q4) * VST_PITCH + 32 * dt + 8 * p4));
            const s16x4 vb2 = __builtin_amdgcn_ds_read_tr16_b64_v4i16((LAS s16x4*)(vb + (16 + 4 * g + q4) * VST_PITCH + 32 * dt + 8 * p4));
            const bf16x8 vt = (bf16x8){va[0], va[1], va[2], va[3], vb2[0], vb2[1], vb2[2], vb2[3]};
            o[dt] = __builtin_amdgcn_mfma_f32_16x16x32_bf16(vt, pb, o[dt], 0, 0, 0);
        }
    }
    const float inv = __builtin_amdgcn_rcpf(ls);
    int l2; asm volatile("v_mbcnt_lo_u32_b32 %0, -1, 0\n\tv_mbcnt_hi_u32_b32 %0, -1, %0" : "=v"(l2));
    bf16_t* op = out0 + (unsigned)((l2 & 15) * DM + 4 * (l2 >> 4));
#pragma unroll
    for (int dt = 0; dt < 4; ++dt) { u32x2 w; w.x = pk2(o[dt][0] * inv, o[dt][1] * inv); w.y = pk2(o[dt][2] * inv, o[dt][3] * inv);
        *(u32x2*)(op + 16 * dt) = w; }
}
constexpr int NA_ROWB = 64 * 128, NA_RING = 9 * NA_ROWB;
__device__ __forceinline__ void na_wave_unit(int lane, const LAS unsigned char* kring, const LAS unsigned char* vring, const bf16x8 (&qf)[2], u32x2 (&ow)[4],
                                             const LAS float* rpb_h, int r, int rs, int cb, int q0) {
    const int c16 = lane & 15, g = lane >> 4;
    float s[16][4];
    const int qc = q0 + c16, cs = min(max(qc - 8, 0), 48);
    const int slot0 = rs % 9;
#define NA_BIAS(dst, t_) do { _Pragma("unroll") for (int j_ = 0; j_ < 4; ++j_) dst[j_] = rpb_h[(rs + ((t_) >> 1) - r + 7) * 31 + min(max(cb + ((t_) & 1) * 16 + 4 * g + j_ - qc + 15, 0), 30)]; } while (0)
    float bv[4]; NA_BIAS(bv, 0);
#pragma unroll
    for (int t = 0; t < 16; ++t) {
        if ((t & 3) == 0) __builtin_amdgcn_sched_barrier(0);
        const int n = t >> 1, half = t & 1;
        const int slot = slot0 + n >= 9 ? slot0 + n - 9 : slot0 + n;
        const int key = cb + half * 16 + c16, sw = key & 7;
        const LAS unsigned char* kr = kring + slot * NA_ROWB + key * 128;
        const bf16x8 k0 = *(const LAS bf16x8*)(kr + ((g ^ sw) << 4)), k1 = *(const LAS bf16x8*)(kr + (((4 + g) ^ sw) << 4));
        float bn[4] = {0.f, 0.f, 0.f, 0.f}; if (t < 15) NA_BIAS(bn, t + 1);
        asm volatile("" : "+v"(bv[0]), "+v"(bv[1]), "+v"(bv[2]), "+v"(bv[3]));
        f32x4 acc = (f32x4){bv[0], bv[1], bv[2], bv[3]};
        acc = __builtin_amdgcn_mfma_f32_16x16x32_bf16(k0, qf[0], acc, 0, 0, 0);
        acc = __builtin_amdgcn_mfma_f32_16x16x32_bf16(k1, qf[1], acc, 0, 0, 0);
#pragma unroll
        for (int j = 0; j < 4; ++j) { const int kc = cb + half * 16 + 4 * g + j; const bool ok = (kc >= cs) && (kc < cs + 16);
            s[t][j] = ok ? acc[j] : -1e30f; }
#pragma unroll
        for (int j = 0; j < 4; ++j) bv[j] = bn[j];
    }
#undef NA_BIAS
    float m = -1e30f;
#pragma unroll
    for (int t = 0; t < 16; ++t)
#pragma unroll
        for (int j = 0; j < 4; ++j) m = fmaxf(m, s[t][j]);
    m = fmaxf(m, __shfl_xor(m, 16)); m = fmaxf(m, __shfl_xor(m, 32));
    float ls = 0.f;
#pragma unroll
    for (int t = 0; t < 16; ++t)
#pragma unroll
        for (int j = 0; j < 4; ++j) { const float p = __builtin_amdgcn_exp2f(s[t][j] - m); s[t][j] = p; ls += p; }
    ls += __shfl_xor(ls, 16); ls += __shfl_xor(ls, 32);
    f32x4 o[4];
#pragma unroll
    for (int dt = 0; dt < 4; ++dt) o[dt] = (f32x4){0.f, 0.f, 0.f, 0.f};
    const int q4 = c16 >> 2, p4 = lane & 3;
    const int keyA = cb + 4 * g + q4, keyB = keyA + 16;
#pragma unroll
    for (int n = 0; n < 8; ++n) {
        const int slot = slot0 + n >= 9 ? slot0 + n - 9 : slot0 + n;
        float pf[8] = {s[2 * n][0], s[2 * n][1], s[2 * n][2], s[2 * n][3], s[2 * n + 1][0], s[2 * n + 1][1], s[2 * n + 1][2], s[2 * n + 1][3]};
        const bf16x8 pb = pack8(pf);
        const LAS unsigned char* va0 = vring + slot * NA_ROWB + keyA * 128 + 8 * (p4 & 1); const LAS unsigned char* vb0 = vring + slot * NA_ROWB + keyB * 128 + 8 * (p4 & 1);
#pragma unroll
        for (int dt = 0; dt < 4; ++dt) {
            const s16x4 va = __builtin_amdgcn_ds_read_tr16_b64_v4i16((LAS s16x4*)(va0 + (((2 * dt + (p4 >> 1)) ^ (keyA & 7)) << 4)));
            const s16x4 vb2 = __builtin_amdgcn_ds_read_tr16_b64_v4i16((LAS s16x4*)(vb0 + (((2 * dt + (p4 >> 1)) ^ (keyB & 7)) << 4)));
            const bf16x8 vt = (bf16x8){va[0], va[1], va[2], va[3], vb2[0], vb2[1], vb2[2], vb2[3]};
            o[dt] = __builtin_amdgcn_mfma_f32_16x16x32_bf16(vt, pb, o[dt], 0, 0, 0);
        }
    }
    const float inv = __builtin_amdgcn_rcpf(ls);
#pragma unroll
    for (int dt = 0; dt < 4; ++dt) { ow[dt].x = pk2(o[dt][0] * inv, o[dt][1] * inv); ow[dt].y = pk2(o[dt][2] * inv, o[dt][3] * inv); }
}
__device__ __forceinline__ void na_load_rows(int tid, LAS unsigned char* kring, LAS unsigned char* vring, const bf16_t* P, int b, int h, int row_first, int nrows, const float* wk) {
    for (int w = tid; w < nrows * 128; w += NTHREADS) {
        const int row = row_first + (w >> 7), kind = (w >> 6) & 1, key = w & 63, slot = row % 9, sw = key & 7;
        const u32x4* src = (const u32x4*)(P + ((size_t)b * SEQ + row * 64 + key) * PA_LD + (kind ? C_V : C_K) + h * 64);
        LAS unsigned char* dst = (kind ? vring : kring) + slot * NA_ROWB + key * 128;
        u32x4 v[8];
#pragma unroll
        for (int c = 0; c < 8; ++c) v[c] = src[c];
        if (kind == 0) {
            float f[64];
#pragma unroll
            for (int c = 0; c < 8; ++c) unpack8(v[c], f + 8 * c);
            float ss = 0.f;
#pragma unroll
            for (int e = 0; e < 64; ++e) ss += f[e] * f[e];
            const float rs = rsqrtf(ss * (1.0f / 64.0f) + 1e-6f);
#pragma unroll
            for (int e = 0; e < 64; ++e) f[e] = f[e] * rs * wk[e];
#pragma unroll
            for (int c = 0; c < 8; ++c) *(LAS bf16x8*)(dst + ((c ^ sw) << 4)) = pack8(f + 8 * c);
        } else {
#pragma unroll
            for (int c = 0; c < 8; ++c) *(LAS u32x4*)(dst + ((c ^ sw) << 4)) = v[c];
        }
    }
}
__device__ __forceinline__ void load_wv(const float* w, int g, float (&wv)[16]) {
#pragma unroll
    for (int e = 0; e < 8; ++e) { wv[e] = w[8 * g + e]; wv[8 + e] = w[32 + 8 * g + e]; }
}
#if !BRUTE_ATTN
__device__ __forceinline__ void mem_unit(Frame& F, int l, int u) {
    const bf16_t* P = WSP(bf16_t, WS_PA); bf16_t* MIX = (bf16_t*)F.out; const bf16_t* MKV = WSP(bf16_t, WS_MEMKV);
    const int g = F.lane >> 4;
    LAS unsigned char* kimg = F.lds; LAS unsigned char* vimg = F.lds + 256 * VST_PITCH;
    float wqv[16]; load_wv(F.in[21] + l * 64, g, wqv);
    const float* wk = F.in[22] + l * 64;
    const int part = u & 7, h = (u >> 3) & 3, b = u >> 5;
    {   const int key = F.tid >> 1, hf = F.tid & 1;
        const bf16_t* src = MKV + ((size_t)b * NMEM + key) * 512 + h * 64 + hf * 32;
        float f[32]; unpack8(*(const u32x4*)src, f); unpack8(*(const u32x4*)(src + 8), f + 8); unpack8(*(const u32x4*)(src + 16), f + 16); unpack8(*(const u32x4*)(src + 24), f + 24);
        float ss = 0.f;
#pragma unroll
        for (int e = 0; e < 32; ++e) ss += f[e] * f[e];
        ss += __shfl_xor(ss, 1);
        const float rs = rsqrtf(ss * (1.0f / 64.0f) + 1e-6f);
#pragma unroll
        for (int e = 0; e < 32; ++e) f[e] = f[e] * rs * wk[hf * 32 + e];
        LAS bf16x8* kd = (LAS bf16x8*)(kimg + key * VST_PITCH + hf * 64);
        kd[0] = pack8(f); kd[1] = pack8(f + 8); kd[2] = pack8(f + 16); kd[3] = pack8(f + 24);
        const u32x4* vs = (const u32x4*)(src + 256); LAS u32x4* vd = (LAS u32x4*)(vimg + key * VST_PITCH + hf * 64);
        vd[0] = vs[0]; vd[1] = vs[1]; vd[2] = vs[2]; vd[3] = vs[3]; }
    __syncthreads();
    for (int i = 0; i < 8; ++i) {
        const int qblk = part * 64 + F.wave * 8 + i; const size_t tok0 = (size_t)b * SEQ + qblk * 16;
        mem_wave_unit(F.lane, kimg, vimg, P + tok0 * PA_LD + C_MQ + h * 64, wqv, MIX + tok0 * DM + 768 + h * 64);
    }
}
constexpr int NA_STEPS = 8, NA_UPH = 64 / NA_STEPS;
__device__ __forceinline__ void na_unit(Frame& F, int l, int u) {
    const bf16_t* P = WSP(bf16_t, WS_PA); bf16_t* MIX = (bf16_t*)F.out;
    const int g = F.lane >> 4, c16 = F.lane & 15;
    LAS unsigned char* kring = F.lds; LAS unsigned char* vring = F.lds + NA_RING;
    LAS float* rpbl = (LAS float*)(F.lds + LDS_RPB);
    float wqv[16]; load_wv(F.in[4] + l * 64, g, wqv);
    const float* wk = F.in[5] + l * 64;
    const int rq = u % NA_UPH, h = (u / NA_UPH) & 7, b = u / (NA_UPH * 8), qb = F.wave & 3;
    const int cb = qb == 0 ? 0 : (qb == 1 ? 8 : (qb == 2 ? 24 : 32));
    { const float* rpb = F.in[6] + ((size_t)l * 8 + h) * 15 * 31; if (F.tid < 465) rpbl[F.tid] = rpb[F.tid] * 1.44269504089f; if (F.tid < 64) rpbl[480 + F.tid] = wk[F.tid]; }
    const int n_rs = F.tid >> 8, n_kind = (F.tid >> 7) & 1, n_key = (F.tid >> 1) & 63, n_half = F.tid & 1;
    const int ra0 = rq * (2 * NA_STEPS);
    const bf16_t* qp = P + ((size_t)b * SEQ + (ra0 + (F.wave >> 2)) * 64 + qb * 16 + c16) * PA_LD + h * 64 + 8 * g;
    int loaded_hi;
    { const int lo = min(max(ra0 - 4, 0), 120), hi = min(max(ra0 + 1 - 4, 0), 120) + 7; na_load_rows(F.tid, kring, vring, P, b, h, lo, hi - lo + 1, wk); loaded_hi = hi; }
    bf16x8 qf[2]; { const u32x4 qr0 = *(const u32x4*)qp, qr1 = *(const u32x4*)(qp + 32); norm_frag(qr0, qr1, wqv, 0.125f * 1.44269504089f, qf); }
    __syncthreads();
    for (int i = 0; i < NA_STEPS; ++i) {
        const int ra = ra0 + 2 * i;
        u32x4 pv[4] = {}, nq0 = {}, nq1 = {}; int n_row = -1;
        if (i + 1 < NA_STEPS) {
            const int hi2 = min(max(ra + 3 - 4, 0), 120) + 7;
            if (loaded_hi + 1 + n_rs <= hi2) n_row = loaded_hi + 1 + n_rs;
            loaded_hi = hi2;
            const u32x4* src = (const u32x4*)(P + ((size_t)b * SEQ + (n_row < 0 ? 0 : n_row) * 64 + n_key) * PA_LD + (n_kind ? C_V : C_K) + h * 64 + n_half * 32);
            if (n_row >= 0) { pv[0] = src[0]; pv[1] = src[1]; pv[2] = src[2]; pv[3] = src[3]; }
            const bf16_t* qn = qp + (size_t)(2 * (i + 1)) * 64 * PA_LD; nq0 = *(const u32x4*)qn; nq1 = *(const u32x4*)(qn + 32);
        }
        const int r = ra + (F.wave >> 2), rs = min(max(r - 4, 0), 120);
        const size_t tok0 = (size_t)b * SEQ + r * 64 + qb * 16;
        u32x2 ow[4];
        na_wave_unit(F.lane, kring, vring, qf, ow, rpbl, r, rs, cb, qb * 16);
        if (i + 1 < NA_STEPS) {
            __syncthreads();
            float f[32];
#pragma unroll
            for (int c = 0; c < 4; ++c) unpack8(pv[c], f + 8 * c);
            float ss = 0.f;
#pragma unroll
            for (int e = 0; e < 32; ++e) ss += f[e] * f[e];
            ss += __shfl_xor(ss, 1);
            const float rsn = rsqrtf(ss * (1.0f / 64.0f) + 1e-6f);
            if (n_row >= 0) {
                LAS unsigned char* dst = (n_kind ? vring : kring) + (n_row % 9) * NA_ROWB + n_key * 128; const int sw = n_key & 7;
                if (n_kind == 0) {
#pragma unroll
                    for (int c = 0; c < 4; ++c) { const f32x4 w0 = *(const LAS f32x4*)(rpbl + 480 + n_half * 32 + 8 * c), w1 = *(const LAS f32x4*)(rpbl + 480 + n_half * 32 + 8 * c + 4);
#pragma unroll
                        for (int e = 0; e < 4; ++e) { f[8 * c + e] *= rsn * w0[e]; f[8 * c + 4 + e] *= rsn * w1[e]; }
                        *(LAS bf16x8*)(dst + (((n_half * 4 + c) ^ sw) << 4)) = pack8(f + 8 * c); }
                } else {
#pragma unroll
                    for (int c = 0; c < 4; ++c) *(LAS u32x4*)(dst + (((n_half * 4 + c) ^ sw) << 4)) = pv[c];
                }
            }
            norm_frag(nq0, nq1, wqv, 0.125f * 1.44269504089f, qf);
        }
        { int l2; asm volatile("v_mbcnt_lo_u32_b32 %0, -1, 0\n\tv_mbcnt_hi_u32_b32 %0, -1, %0" : "=v"(l2));
          bf16_t* op = MIX + tok0 * DM + h * 64 + (unsigned)((l2 & 15) * DM + 4 * (l2 >> 4));
#pragma unroll
          for (int dt = 0; dt < 4; ++dt) *(u32x2*)(op + 16 * dt) = ow[dt]; }
        if (i + 1 < NA_STEPS) __syncthreads();
    }
}
#endif
#if BRUTE_ATTN
__device__ __forceinline__ void phase_attn(Frame& F, int l) {
    const bf16_t* P = WSP(bf16_t, WS_PA); bf16_t* MIX = (bf16_t*)F.out; const bf16_t* MKV = WSP(bf16_t, WS_MEMKV);
    const int h = F.tid >> 6, d = F.tid & 63;
    for (int tok = F.bid; tok < NT; tok += GRID) {
        const int b = tok >> 13, sidx = tok & (SEQ - 1), r = sidx >> 6, c = sidx & 63;
        {   const float* wq = F.in[4] + l * 64; const float* wk = F.in[5] + l * 64; const float* rpb = F.in[6] + (size_t)l * 8 * 15 * 31;
            float q[64]; float ss = 0.f;
#pragma unroll
            for (int i = 0; i < 64; ++i) { q[i] = bf2f(P[(size_t)tok * PIN + h * 64 + i]); ss += q[i] * q[i]; }
            { const float rs = 1.0f / sqrtf(ss / 64.0f + 1e-6f);
#pragma unroll
              for (int i = 0; i < 64; ++i) q[i] = q[i] * rs * wq[i] * wk[i]; }
            const int rs0 = min(max(r - 4, 0), 120), cs0 = min(max(c - 8, 0), 48);
            float mx = -1e30f, den = 0.f, o = 0.f;
#pragma unroll 1
            for (int pass = 0; pass < 2; ++pass)
#pragma unroll 1
                for (int nm = 0; nm < 128; ++nm) { const int n = nm >> 4, m = nm & 15;
                    const size_t kt = (size_t)b * SEQ + (rs0 + n) * 64 + cs0 + m; const bf16_t* kp = P + kt * PIN + C_K + h * 64;
                    float ks = 0.f, dt = 0.f;
#pragma unroll
                    for (int i8 = 0; i8 < 8; ++i8) { const u32x4 kv4 = ((const u32x4*)kp)[i8]; const unsigned kw[4] = {kv4.x, kv4.y, kv4.z, kv4.w};
#pragma unroll
                        for (int e = 0; e < 4; ++e) { const float k0 = bflo(kw[e]), k1 = bfhi(kw[e]); ks += k0 * k0 + k1 * k1; dt += q[i8 * 8 + 2 * e] * k0 + q[i8 * 8 + 2 * e + 1] * k1; } }
                    const float s = dt / sqrtf(ks / 64.0f + 1e-6f) * 0.125f + rpb[((size_t)h * 15 + (rs0 + n - r + 7)) * 31 + (cs0 + m - c + 15)];
                    if (pass == 0) mx = fmaxf(mx, s); else { const float p = expf(s - mx); den += p; o += p * bf2f(P[kt * PIN + C_V + h * 64 + d]); }
                }
            MIX[(size_t)tok * DM + h * 64 + d] = f2bf(o / den);
        }
    }
    __syncthreads();
    for (int tok = F.bid; tok < NT; tok += GRID) {
        const int b = tok >> 13;
        if (F.tid < 256) {
            const float* wq = F.in[21] + l * 64; const float* wk = F.in[22] + l * 64;
            float q[64]; float ss = 0.f;
#pragma unroll
            for (int i = 0; i < 64; ++i) { q[i] = bf2f(P[(size_t)tok * PIN + C_MQ + h * 64 + i]); ss += q[i] * q[i]; }
            { const float rs = 1.0f / sqrtf(ss / 64.0f + 1e-6f);
#pragma unroll
              for (int i = 0; i < 64; ++i) q[i] = q[i] * rs * wq[i] * wk[i]; }
            float mx = -1e30f, den = 0.f, o = 0.f;
#pragma unroll 1
            for (int pass = 0; pass < 2; ++pass)
#pragma unroll 1
                for (int m = 0; m < NMEM; ++m) {
                    const bf16_t* kp = MKV + ((size_t)b * NMEM + m) * 512 + h * 64;
                    float ks = 0.f, dt = 0.f;
#pragma unroll
                    for (int i8 = 0; i8 < 8; ++i8) { const u32x4 kv4 = ((const u32x4*)kp)[i8]; const unsigned kw[4] = {kv4.x, kv4.y, kv4.z, kv4.w};
#pragma unroll
                        for (int e = 0; e < 4; ++e) { const float k0 = bflo(kw[e]), k1 = bfhi(kw[e]); ks += k0 * k0 + k1 * k1; dt += q[i8 * 8 + 2 * e] * k0 + q[i8 * 8 + 2 * e + 1] * k1; } }
                    const float s = dt / sqrtf(ks / 64.0f + 1e-6f) * 0.125f;
                    if (pass == 0) mx = fmaxf(mx, s); else { const float p = expf(s - mx); den += p; o += p * bf2f(kp[256 + d]); }
                }
            MIX[(size_t)tok * DM + 768 + h * 64 + d] = f2bf(o / den);
        }
    }
}
#endif

#if NAIVE_SCAN
__device__ __forceinline__ void phase_scan(Frame& F, int l) {
    if (F.wave != 0 || F.bid >= 64) return;
    const int id = F.bid, b = id >> 3, h = (id >> 1) & 3, dir = id & 1, lane = F.lane;
    LAS float* L = (LAS float*)F.lds;
    const bf16_t* Rb = RWBUF(0); const bf16_t* Kb = RWBUF(1); const bf16_t* KKb = RWBUF(2); const bf16_t* Vb = RWBUF(3);
    const bf16_t* Eb = RWBUF(4 + dir); const bf16_t* Ab = RWBUF(6 + dir);
    bf16_t* Y = (bf16_t*)(F.ws + WS_Y + (size_t)dir * RWB);
    const float ka = F.in[15][l * 256 + h * 64 + lane];
    const size_t base = (size_t)b * SEQ * 256 + h * 64 + lane;
    float S[64];
#pragma unroll
    for (int k = 0; k < 64; ++k) S[k] = 0.f;
    size_t o = base + (size_t)(dir ? SEQ - 1 : 0) * 256;
    bf16_t nr = Rb[o], nk = Kb[o], nkk = KKb[o], nv = Vb[o], ne = Eb[o], na = Ab[o];
    for (int step = 0; step < SEQ; ++step) {
        const int t = dir ? SEQ - 1 - step : step;
        const float r = bf2f(nr), k = bf2f(nk), kk = bf2f(nkk), v = bf2f(nv), e = bf2f(ne), a = bf2f(na);
        if (step + 1 < SEQ) { o = base + (size_t)(dir ? t - 1 : t + 1) * 256; nr = Rb[o]; nk = Kb[o]; nkk = KKb[o]; nv = Vb[o]; ne = Eb[o]; na = Ab[o]; }
        const float w = __expf(-e), kd = k * (1.0f + (a - 1.0f) * ka), bt = kk * a;
        asm volatile("" ::: "memory");
        L[lane] = w; L[64 + lane] = kk; L[128 + lane] = bt; L[192 + lane] = kd; L[256 + lane] = r;
        asm volatile("s_waitcnt lgkmcnt(0)" ::: "memory");
        float s0 = 0.f, s1 = 0.f, s2 = 0.f, s3 = 0.f;
#pragma unroll
        for (int k4 = 0; k4 < 16; ++k4) { const f32x4 x = *(const LAS f32x4*)(L + 64 + k4 * 4); s0 += S[k4 * 4] * x[0]; s1 += S[k4 * 4 + 1] * x[1]; s2 += S[k4 * 4 + 2] * x[2]; s3 += S[k4 * 4 + 3] * x[3]; }
        const float sa = -((s0 + s1) + (s2 + s3));
        float y0 = 0.f, y1 = 0.f, y2 = 0.f, y3 = 0.f;
#pragma unroll
        for (int k4 = 0; k4 < 16; ++k4) {
            const f32x4 w4 = *(const LAS f32x4*)(L + k4 * 4), b4 = *(const LAS f32x4*)(L + 128 + k4 * 4), d4 = *(const LAS f32x4*)(L + 192 + k4 * 4), r4 = *(const LAS f32x4*)(L + 256 + k4 * 4);
            S[k4 * 4] = S[k4 * 4] * w4[0] + sa * b4[0] + v * d4[0]; y0 += S[k4 * 4] * r4[0];
            S[k4 * 4 + 1] = S[k4 * 4 + 1] * w4[1] + sa * b4[1] + v * d4[1]; y1 += S[k4 * 4 + 1] * r4[1];
            S[k4 * 4 + 2] = S[k4 * 4 + 2] * w4[2] + sa * b4[2] + v * d4[2]; y2 += S[k4 * 4 + 2] * r4[2];
            S[k4 * 4 + 3] = S[k4 * 4 + 3] * w4[3] + sa * b4[3] + v * d4[3]; y3 += S[k4 * 4 + 3] * r4[3];
        }
        Y[base + (size_t)t * 256] = f2bf((y0 + y1) + (y2 + y3));
        asm volatile("" ::: "memory");
    }
}

#else
typedef short s16x4 __attribute__((ext_vector_type(4)));
constexpr int CHSZ = 10240;
constexpr int CH_AT = 0, CH_R = 2048, CH_F8 = 4096, CH_GAM = 9728;
#define CH_F8OFF(k, lane) (CH_F8 + ((k) < 10 ? ((k) >> 1) * 1024 + (lane) * 16 + ((k) & 1) * 8 : 5120 + (lane) * 8))
constexpr int IMG_PITCH = 144, WL_AH = 0, WL_BT = 2304, WL_KT = 4608, WL_T = 6912, WL_MKA = 7424, WL_MBAT = 7936, WL_BYTES = 8960;
#define DPP_SHR(x, n) __builtin_bit_cast(float, __builtin_amdgcn_update_dpp(0, __builtin_bit_cast(int, (x)), 0x110 + (n), 0xf, 0xf, true))
__device__ __forceinline__ f32x4 mfma16x2(const s16x4 a0, const s16x4 b0, const s16x4 a1, const s16x4 b1, const f32x4 c) {
    const bf16x8 a8 = (bf16x8){a0[0], a0[1], a0[2], a0[3], a1[0], a1[1], a1[2], a1[3]}, b8 = (bf16x8){b0[0], b0[1], b0[2], b0[3], b1[0], b1[1], b1[2], b1[3]};
    return __builtin_amdgcn_mfma_f32_16x16x32_bf16(a8, b8, c, 0, 0, 0);
}
__device__ __forceinline__ f32x4 mfma16pad(const s16x4 a, const s16x4 bq, const f32x4 c, int, int, int) {
    const bf16x8 a8 = (bf16x8){a[0], a[1], a[2], a[3], 0, 0, 0, 0}, b8 = (bf16x8){bq[0], bq[1], bq[2], bq[3], 0, 0, 0, 0};
    return __builtin_amdgcn_mfma_f32_16x16x32_bf16(a8, b8, c, 0, 0, 0);
}
__device__ __forceinline__ s16x4 pack4(const f32x4 v) { u32x2 w; w.x = pk2(v[0], v[1]); w.y = pk2(v[2], v[3]); return __builtin_bit_cast(s16x4, w); }
__device__ __forceinline__ bf16x8 pack44(const f32x4 a, const f32x4 b) { u32x4 w; w.x = pk2(a[0], a[1]); w.y = pk2(a[2], a[3]); w.z = pk2(b[0], b[1]); w.w = pk2(b[2], b[3]); return __builtin_bit_cast(bf16x8, w); }
__device__ __forceinline__ void load16(const bf16_t* p, int g, float (&f)[16]) {
#pragma unroll
    for (int q = 0; q < 4; ++q) { const u32x2 v = *(const u32x2*)(p + 16 * q + 4 * g); f[4 * q] = bflo(v.x); f[4 * q + 1] = bfhi(v.x); f[4 * q + 2] = bflo(v.y); f[4 * q + 3] = bfhi(v.y); }
}
__device__ __forceinline__ void store_img(LAS unsigned char* img, int step, int g, const float (&f)[16]) {
#pragma unroll
    for (int q = 0; q < 4; ++q) { u32x2 w; w.x = pk2(f[4 * q], f[4 * q + 1]); w.y = pk2(f[4 * q + 2], f[4 * q + 3]); *(LAS u32x2*)(img + step * IMG_PITCH + (16 * q + 4 * g) * 2) = w; }
}
struct ChunkRaw { u32x2 r[4], k[4], kk[4], e[4], a[4]; };
__device__ __forceinline__ void chunk_fetch(ChunkRaw& c, const bf16_t* Rb, const bf16_t* Kb, const bf16_t* KKb, const bf16_t* Eb, const bf16_t* Ab, size_t rowo  , int g) {
#pragma unroll
    for (int q = 0; q < 4; ++q) { const size_t o = rowo + 16 * q + 4 * g; c.r[q] = *(const u32x2*)(Rb + o); c.k[q] = *(const u32x2*)(Kb + o); c.kk[q] = *(const u32x2*)(KKb + o); c.e[q] = *(const u32x2*)(Eb + o); c.a[q] = *(const u32x2*)(Ab + o); }
}
__device__ __forceinline__ void unpack16(const u32x2 (&v)[4], float (&f)[16]) {
#pragma unroll
    for (int q = 0; q < 4; ++q) { f[4 * q] = bflo(v[q].x); f[4 * q + 1] = bfhi(v[q].x); f[4 * q + 2] = bflo(v[q].y); f[4 * q + 3] = bfhi(v[q].y); }
}
__device__ __forceinline__ void rwkv_chunk_unit(int lane, LAS unsigned char* wl, const ChunkRaw& raw, const float (&kav)[16], unsigned char* ch) {
    const int st = lane & 15, g = lane >> 4, q4 = st >> 2, p4 = lane & 3;
    float r[16], k[16], kk[16], e[16], a[16];
    unpack16(raw.r, r); unpack16(raw.k, k); unpack16(raw.kk, kk); unpack16(raw.e, e); unpack16(raw.a, a);
    float Ah[16], Bh[16], Kh[16], Rh[16], Bt[16], Kt[16];
#pragma unroll
    for (int x = 0; x < 16; ++x) {
        float E = e[x]; E += DPP_SHR(E, 1); E += DPP_SHR(E, 2); E += DPP_SHR(E, 4); E += DPP_SHR(E, 8);
        const float EC = __builtin_bit_cast(float, __builtin_amdgcn_update_dpp(0, __builtin_bit_cast(int, E), 0x15F, 0xf, 0xf, true));
        const float gm = __expf(-EC);
        const float xm = __expf(e[x] - E), xp = __expf(E), xn = __expf(-E), xt = xp * gm;
        const float be = kk[x] * a[x], kd = k[x] * (1.0f + (a[x] - 1.0f) * kav[x]);
        Ah[x] = -kk[x] * xm; Bh[x] = be * xp; Kh[x] = kd * xp; Rh[x] = r[x] * xn; Bt[x] = be * xt; Kt[x] = kd * xt;
        e[x] = gm;
    }
    store_img(wl + WL_AH, st, g, Ah); store_img(wl + WL_BT, st, g, Bt); store_img(wl + WL_KT, st, g, Kt);
    if (st >= 12) {
        const int q = st - 12; f32x4 gq;
#pragma unroll
        for (int j = 0; j < 4; ++j) gq[j] = q == 0 ? e[j] : (q == 1 ? e[4 + j] : (q == 2 ? e[8 + j] : e[12 + j]));
        __builtin_nontemporal_store(gq, (f32x4*)(ch + CH_GAM + (16 * q + 4 * g) * 4));
    }
    bf16x8 AhF[2], BhF[2], KhF[2], RhF[2];
#pragma unroll
    for (int s = 0; s < 2; ++s) { AhF[s] = pack8(Ah + 8 * s); BhF[s] = pack8(Bh + 8 * s); KhF[s] = pack8(Kh + 8 * s); RhF[s] = pack8(Rh + 8 * s); }
    const f32x4 z4 = (f32x4){0.f, 0.f, 0.f, 0.f};
    f32x4 p1 = __builtin_amdgcn_mfma_f32_16x16x32_bf16(BhF[0], AhF[0], z4, 0, 0, 0); p1 = __builtin_amdgcn_mfma_f32_16x16x32_bf16(BhF[1], AhF[1], p1, 0, 0, 0);
    f32x4 p2 = __builtin_amdgcn_mfma_f32_16x16x32_bf16(AhF[0], KhF[0], z4, 0, 0, 0); p2 = __builtin_amdgcn_mfma_f32_16x16x32_bf16(AhF[1], KhF[1], p2, 0, 0, 0);
    f32x4 p3 = __builtin_amdgcn_mfma_f32_16x16x32_bf16(BhF[0], RhF[0], z4, 0, 0, 0); p3 = __builtin_amdgcn_mfma_f32_16x16x32_bf16(BhF[1], RhF[1], p3, 0, 0, 0);
    f32x4 pr4 = __builtin_amdgcn_mfma_f32_16x16x32_bf16(KhF[0], RhF[0], z4, 0, 0, 0); pr4 = __builtin_amdgcn_mfma_f32_16x16x32_bf16(KhF[1], RhF[1], pr4, 0, 0, 0);
#pragma unroll
    for (int jj = 0; jj < 4; ++jj) { const int row = 4 * g + jj;
        p1[jj] = row < st ? p1[jj] : 0.f;
        p2[jj] = st < row ? p2[jj] : 0.f;
        p3[jj] = row <= st ? p3[jj] : 0.f;
        pr4[jj] = row <= st ? pr4[jj] : 0.f; }
    *(LAS f32x4*)(wl + WL_MBAT + (st * 16 + 4 * g) * 4) = p1;
    *(LAS s16x4*)(wl + WL_MKA + (st * 16 + 4 * g) * 2) = pack4(p2);
    const s16x4 fMBR = pack4(p3), fMKR = pack4(pr4);
    float x[16];
#pragma unroll
    for (int i = 0; i < 16; ++i) {
        float acc = (st == i) ? 1.0f : 0.0f;
#pragma unroll
        for (int j4 = 0; j4 < (i + 3) / 4; ++j4) { const f32x4 mm = *(const LAS f32x4*)(wl + WL_MBAT + (i * 16 + 4 * j4) * 4);
#pragma unroll
            for (int jj = 0; jj < 4; ++jj) if (4 * j4 + jj < i) acc += x[4 * j4 + jj] * mm[jj]; }
        x[i] = acc;
    }
    if (g == 0) { *(LAS bf16x8*)(wl + WL_T + st * 32) = pack8(x); *(LAS bf16x8*)(wl + WL_T + st * 32 + 16) = pack8(x + 8); }
    const s16x4 tB = __builtin_amdgcn_ds_read_tr16_b64_v4i16((LAS s16x4*)(wl + WL_T + (4 * g + q4) * 32 + 8 * p4));
    f32x4 at[4];
#pragma unroll
    for (int t = 0; t < 4; ++t) { const s16x4 aA = __builtin_amdgcn_ds_read_tr16_b64_v4i16((LAS s16x4*)(wl + WL_AH + (4 * g + q4) * IMG_PITCH + 32 * t + 8 * p4));
        at[t] = mfma16pad(aA, tB, z4, 0, 0, 0); }
    __builtin_nontemporal_store((bf16x8)(pack44(at[0], at[1])), (bf16x8*)(ch + CH_AT + lane * 16)); __builtin_nontemporal_store((bf16x8)(pack44(at[2], at[3])), (bf16x8*)(ch + CH_AT + 1024 + lane * 16));
    { const s16x4 mA = *(const LAS s16x4*)(wl + WL_MKA + (st * 16 + 4 * g) * 2);
      const f32x4 mt = mfma16pad(mA, tB, z4, 0, 0, 0);
      const s16x4 fMT = pack4(mt);
      __builtin_nontemporal_store((bf16x8){fMT[0], fMT[1], fMT[2], fMT[3], fMBR[0], fMBR[1], fMBR[2], fMBR[3]}, (bf16x8*)(ch + CH_F8OFF(0, lane))); }
    __builtin_nontemporal_store((bf16x8)(RhF[0]), (bf16x8*)(ch + CH_R + lane * 16)); __builtin_nontemporal_store((bf16x8)(RhF[1]), (bf16x8*)(ch + CH_R + 1024 + lane * 16));
    s16x4 fb[4], fk[4];
#pragma unroll
    for (int t = 0; t < 4; ++t) {
        fb[t] = __builtin_amdgcn_ds_read_tr16_b64_v4i16((LAS s16x4*)(wl + WL_BT + (4 * g + q4) * IMG_PITCH + 32 * t + 8 * p4));
        fk[t] = __builtin_amdgcn_ds_read_tr16_b64_v4i16((LAS s16x4*)(wl + WL_KT + (4 * g + q4) * IMG_PITCH + 32 * t + 8 * p4)); }
#define CH_PAIR(a_, b_) (bf16x8){a_[0], a_[1], a_[2], a_[3], b_[0], b_[1], b_[2], b_[3]}
    __builtin_nontemporal_store(CH_PAIR(fMKR, fb[0]), (bf16x8*)(ch + CH_F8OFF(2, lane)));
    __builtin_nontemporal_store(CH_PAIR(fb[1], fb[2]), (bf16x8*)(ch + CH_F8OFF(4, lane)));
    __builtin_nontemporal_store(CH_PAIR(fb[3], fk[0]), (bf16x8*)(ch + CH_F8OFF(6, lane)));
    __builtin_nontemporal_store(CH_PAIR(fk[1], fk[2]), (bf16x8*)(ch + CH_F8OFF(8, lane)));
    __builtin_nontemporal_store(fk[3], (s16x4*)(ch + CH_F8OFF(10, lane)));
#undef CH_PAIR
}
#define RWP_BAR() do { asm volatile("" ::: "memory"); __builtin_amdgcn_s_barrier(); asm volatile("" ::: "memory"); } while (0)
constexpr int RWP_SLOT = 7 * 4 * 512;
__device__ __forceinline__ void phase_rwprep(Frame& F, int l) {
    const char* P = (const char*)WSP(bf16_t, WS_PR);
    LAS float* cst = (LAS float*)F.lds;
    const int pw_ = F.wave & 3;
    LAS unsigned char* slot = F.lds + RL_N * 4 + pw_ * RWP_SLOT;
    LAS unsigned char* wl = F.lds + RL_N * 4 + 4 * RWP_SLOT + pw_ * WL_BYTES;
    unsigned char* CH = F.ws + WS_CH;
    {   const float* mup = F.in[7] + l * 1152; const float* mun = F.in[8] + l * 1152; const float* w0 = F.in[9] + l * 512; const float* a0 = F.in[11] + l * 512;
        const float* k_k = F.in[14] + l * 256; const float* k_a = F.in[15] + l * 256; const float* r_k = F.in[16] + l * 256;
        for (int i = F.tid; i < 1152; i += NTHREADS) { cst[RL_MUP + i] = mup[i]; cst[RL_MUN + i] = mun[i]; }
        { const int i = F.tid; cst[RL_W0 + i] = w0[i]; cst[RL_A0 + i] = a0[i]; if (i < 256) { cst[RL_KK + i] = k_k[i]; cst[RL_KA + i] = k_a[i]; cst[RL_RK + i] = r_k[i]; } }
        __syncthreads(); }
    const char* W2T = (const char*)WSP(bf16_t, WS_LORA + (size_t)l * LORA_STRIDE); const char* A2T = W2T + 2 * 256 * 64 * 2; const char* G2T = A2T + 2 * 256 * 64 * 2;
    if (F.wave >= 4) {
        __builtin_amdgcn_s_setprio(2);
        for (int un = F.bid * 4 + pw_; un < NT / 16; un += GRID * 4) {
#pragma unroll 1
            for (int hh_ = 0; hh_ < 4; ++hh_) {
                int hh = hh_; asm volatile("" : "+v"(hh)); hh = __builtin_amdgcn_readfirstlane(hh);
                RWP_BAR();
                RWP_BAR();
                int lane; asm volatile("v_mbcnt_lo_u32_b32 %0, -1, 0\n\tv_mbcnt_hi_u32_b32 %0, -1, %0" : "=v"(lane));
                const int g = lane >> 4, cb_ = un >> 9, cc_ = un & 511;
                float kav[16];
#pragma unroll
                for (int q = 0; q < 4; ++q) { const f32x4 v4 = *(const LAS f32x4*)(cst + RL_KA + hh * 64 + 16 * q + 4 * g); kav[4 * q] = v4[0]; kav[4 * q + 1] = v4[1]; kav[4 * q + 2] = v4[2]; kav[4 * q + 3] = v4[3]; }
#pragma unroll 1
                for (int dir_ = 0; dir_ < 2; ++dir_) {
                    int dir = dir_; asm volatile("" : "+v"(dir)); dir = __builtin_amdgcn_readfirstlane(dir);
                    const int ls = dir ? ((lane & 48) | (15 - (lane & 15))) : lane;
                    const LAS unsigned char* sp = slot + ls * 8;
                    ChunkRaw cr;
#pragma unroll
                    for (int q = 0; q < 4; ++q) { cr.r[q] = *(const LAS u32x2*)(sp + (0 * 4 + q) * 512); cr.k[q] = *(const LAS u32x2*)(sp + (1 * 4 + q) * 512); cr.kk[q] = *(const LAS u32x2*)(sp + (2 * 4 + q) * 512);
                        cr.e[q] = *(const LAS u32x2*)(sp + ((3 + dir) * 4 + q) * 512); cr.a[q] = *(const LAS u32x2*)(sp + ((5 + dir) * 4 + q) * 512); }
                    rwkv_chunk_unit(lane, wl, cr, kav, CH + ((size_t)((cb_ * 4 + hh) * 2 + dir) * 512 + (dir ? 511 - cc_ : cc_)) * CHSZ);
                }
            }
        }
        __builtin_amdgcn_s_setprio(0);
        return;
    }
    for (int un = F.bid * 4 + pw_; un < NT / 16; un += GRID * 4) {
        int lane; asm volatile("v_mbcnt_lo_u32_b32 %0, -1, 0\n\tv_mbcnt_hi_u32_b32 %0, -1, %0" : "=v"(lane));
        const int c16 = lane & 15, g = lane >> 4;
        const unsigned lo64 = (unsigned)(c16 * 64 + 8 * g) * 2u, lo128 = (unsigned)(c16 * 128 + 8 * g) * 2u;
        const unsigned tok = (unsigned)un * 16u + (unsigned)c16; const int t = (int)(tok & (SEQ - 1));
        const unsigned rowb = tok * (unsigned)(PR_LD * 2);
        bf16x8 fwf[2], fwb[2], faf[2], fab[2], fg[4];
        {   Sh8Raw rw[4]; float o[8];
#pragma unroll
            for (int s = 0; s < 2; ++s) { rw_load8(P, rowb, t, 768 + 32 * s + 8 * g, rw[s]); rw_load8(P, rowb, t, 832 + 32 * s + 8 * g, rw[2 + s]); }
#pragma unroll
            for (int s = 0; s < 2; ++s) {
                rw_shift8(rw[s], t, 768 + 32 * s + 8 * g, cst, o);
#pragma unroll
                for (int e = 0; e < 8; ++e) o[e] = 1.0f - 2.0f * __builtin_amdgcn_rcpf(1.0f + __expf(2.0f * o[e]));
                fwf[s] = pack8(o);
                rw_shift8(rw[2 + s], t, 832 + 32 * s + 8 * g, cst, o);
#pragma unroll
                for (int e = 0; e < 8; ++e) o[e] = 1.0f - 2.0f * __builtin_amdgcn_rcpf(1.0f + __expf(2.0f * o[e]));
                fwb[s] = pack8(o); }
            __builtin_amdgcn_sched_barrier(0);
#pragma unroll
            for (int s = 0; s < 2; ++s) { rw_load8(P, rowb, t, 896 + 32 * s + 8 * g, rw[s]); rw_load8(P, rowb, t, 960 + 32 * s + 8 * g, rw[2 + s]); }
#pragma unroll
            for (int s = 0; s < 2; ++s) { rw_shift8(rw[s], t, 896 + 32 * s + 8 * g, cst, o); faf[s] = pack8(o); rw_shift8(rw[2 + s], t, 960 + 32 * s + 8 * g, cst, o); fab[s] = pack8(o); }
            __builtin_amdgcn_sched_barrier(0);
#pragma unroll
            for (int s = 0; s < 4; ++s) rw_load8(P, rowb, t, 1024 + 32 * s + 8 * g, rw[s]);
#pragma unroll
            for (int s = 0; s < 4; ++s) { rw_shift8(rw[s], t, 1024 + 32 * s + 8 * g, cst, o);
#pragma unroll
                for (int e = 0; e < 8; ++e) o[e] = sigmoidf_(o[e]);
                fg[s] = pack8(o); }
            __builtin_amdgcn_sched_barrier(0);
        }
        const unsigned ob = tok * 512u;
#pragma unroll 1
        for (int hh_ = 0; hh_ < 4; ++hh_) {
            int hh = hh_; asm volatile("" : "+v"(hh)); hh = __builtin_amdgcn_readfirstlane(hh);
            f32x4 kxs[4], vs[4]; float ssq = 0.f, bsum = 0.f; u32x2 pw[4][8];
#pragma unroll
            for (int ct4 = 0; ct4 < 4; ++ct4) {
                __builtin_amdgcn_sched_barrier(0);
                const int c0 = hh * 64 + ct4 * 16;
                const int cb = c0 + 4 * g;
                const char* w2f = W2T + (size_t)c0 * 128; const char* w2b = W2T + (size_t)(256 + c0) * 128; const char* a2f = A2T + (size_t)c0 * 128; const char* a2b = A2T + (size_t)(256 + c0) * 128;
                const char* g2p = G2T + (size_t)c0 * 256;
                bf16x8 wA[12]; Sh4Raw rr, rk, rv;
#pragma unroll
                for (int s = 0; s < 2; ++s) { wA[4 * s] = *(const bf16x8*)(w2f + (lo64 + 64 * s)); wA[4 * s + 1] = *(const bf16x8*)(w2b + (lo64 + 64 * s)); wA[4 * s + 2] = *(const bf16x8*)(a2f + (lo64 + 64 * s)); wA[4 * s + 3] = *(const bf16x8*)(a2b + (lo64 + 64 * s)); }
#pragma unroll
                for (int s = 0; s < 4; ++s) wA[8 + s] = *(const bf16x8*)(g2p + (lo128 + 64 * s));
                rw_load4(P, rowb, t, cb, rr); rw_load4(P, rowb, t, 256 + cb, rk); rw_load4(P, rowb, t, 512 + cb, rv);
                const f32x4 z4 = (f32x4){0.f, 0.f, 0.f, 0.f};
                f32x4 awf = z4, awb = z4, aaf = z4, aab = z4, ag = z4;
#pragma unroll
                for (int s = 0; s < 2; ++s) {
                    awf = __builtin_amdgcn_mfma_f32_16x16x32_bf16(wA[4 * s], fwf[s], awf, 0, 0, 0);
                    awb = __builtin_amdgcn_mfma_f32_16x16x32_bf16(wA[4 * s + 1], fwb[s], awb, 0, 0, 0);
                    aaf = __builtin_amdgcn_mfma_f32_16x16x32_bf16(wA[4 * s + 2], faf[s], aaf, 0, 0, 0);
                    aab = __builtin_amdgcn_mfma_f32_16x16x32_bf16(wA[4 * s + 3], fab[s], aab, 0, 0, 0); }
#pragma unroll
                for (int s = 0; s < 4; ++s) ag = __builtin_amdgcn_mfma_f32_16x16x32_bf16(wA[8 + s], fg[s], ag, 0, 0, 0);
                const f32x4 r = rw_shift4(rr, t, cb, cst), k = rw_shift4(rk, t, 256 + cb, cst), v = rw_shift4(rv, t, 512 + cb, cst);
                const f32x4 w0f = *(const LAS f32x4*)(cst + RL_W0 + cb), w0b = *(const LAS f32x4*)(cst + RL_W0 + 256 + cb), a0f = *(const LAS f32x4*)(cst + RL_A0 + cb), a0b = *(const LAS f32x4*)(cst + RL_A0 + 256 + cb);
                const f32x4 kkc = *(const LAS f32x4*)(cst + RL_KK + cb), kac = *(const LAS f32x4*)(cst + RL_KA + cb), rkc = *(const LAS f32x4*)(cst + RL_RK + cb);
                f32x4 ef, eb, af, ab;
#pragma unroll
                for (int j = 0; j < 4; ++j) {
                    ef[j] = 0.60653065971f * sigmoidf_(w0f[j] + awf[j]);
                    eb[j] = 0.60653065971f * sigmoidf_(w0b[j] + awb[j]);
                    af[j] = sigmoidf_(a0f[j] + aaf[j]); ab[j] = sigmoidf_(a0b[j] + aab[j]); }
                const f32x4 kx = k * kkc;
                const f32x4 kdsum = k * (2.0f + (af + ab - 2.0f) * kac);
                const f32x4 bq = r * kdsum * rkc;
                ssq += (kx[0] * kx[0] + kx[1] * kx[1]) + (kx[2] * kx[2] + kx[3] * kx[3]); bsum += (bq[0] + bq[1]) + (bq[2] + bq[3]);
                kxs[ct4] = kx; vs[ct4] = v;
                pw[ct4][0] = pk4(r); pw[ct4][1] = pk4(k); pw[ct4][2] = pk4(v); pw[ct4][3] = pk4(ef); pw[ct4][4] = pk4(eb); pw[ct4][5] = pk4(af); pw[ct4][6] = pk4(ab); pw[ct4][7] = pk4(ag);
            }
            ssq += __shfl_xor(ssq, 16); ssq += __shfl_xor(ssq, 32); bsum += __shfl_xor(bsum, 16); bsum += __shfl_xor(bsum, 32);
            const float rn = 1.0f / fmaxf(sqrtf(ssq), 1e-12f);
#pragma unroll
            for (int ct4 = 0; ct4 < 4; ++ct4) { const unsigned oo = ob + (unsigned)(hh * 64 + ct4 * 16 + 4 * g) * 2u;
                *(u32x2*)((char*)RWBUF(3) + oo) = pw[ct4][2]; *(u32x2*)((char*)RWBUF(8) + oo) = pw[ct4][7]; *(u32x2*)((char*)RWBUF(9) + oo) = pk4(vs[ct4] * bsum); }
            RWP_BAR();
            { LAS unsigned char* sp = slot + lane * 8;
#pragma unroll
              for (int ct4 = 0; ct4 < 4; ++ct4) {
                  *(LAS u32x2*)(sp + (0 * 4 + ct4) * 512) = pw[ct4][0]; *(LAS u32x2*)(sp + (1 * 4 + ct4) * 512) = pw[ct4][1]; *(LAS u32x2*)(sp + (2 * 4 + ct4) * 512) = pk4(kxs[ct4] * rn);
                  *(LAS u32x2*)(sp + (3 * 4 + ct4) * 512) = pw[ct4][3]; *(LAS u32x2*)(sp + (4 * 4 + ct4) * 512) = pw[ct4][4]; *(LAS u32x2*)(sp + (5 * 4 + ct4) * 512) = pw[ct4][5]; *(LAS u32x2*)(sp + (6 * 4 + ct4) * 512) = pw[ct4][6]; } }
            asm volatile("s_waitcnt lgkmcnt(0)" ::: "memory");
            RWP_BAR();
        }
    }
}
#undef RWP_BAR
#define SCAN_BAR() do { asm volatile("" ::: "memory"); __builtin_amdgcn_s_barrier(); asm volatile("" ::: "memory"); } while (0)
constexpr int SCAN_D = 8, SCAN_R = 9, SLOTB = CHSZ + 2048;
__device__ __forceinline__ void scan_issue(__amdgpu_buffer_rsrc_t rsC, __amdgpu_buffer_rsrc_t rsV, LAS unsigned char* ring, int slot, int chunk, int p0, int lane, int dir, unsigned vlane) {
#pragma unroll
    for (int p = 0; p < 3; ++p) {
        const int pc = p0 + p;
        LAS unsigned* dst = (LAS unsigned*)(ring + slot * SLOTB + pc * 1024);
        if (pc < 10) __builtin_amdgcn_raw_ptr_buffer_load_lds(rsC, dst, 16, (unsigned)lane * 16u, (unsigned)chunk * (unsigned)CHSZ + (unsigned)pc * 1024u, 0, 2);
        else { const int tau = 16 * chunk + (pc - 10) * 8 + (lane >> 3), t = dir ? SEQ - 1 - tau : tau;
            __builtin_amdgcn_raw_ptr_buffer_load_lds(rsV, dst, 16, (unsigned)t * 512u + vlane, 0u, 0, 0); }
    }
}
__device__ __forceinline__ void scan_loader(__amdgpu_buffer_rsrc_t rsC, __amdgpu_buffer_rsrc_t rsV, LAS unsigned char* ring, int p0, int lane, int dir, unsigned vlane) {
    for (int cc = 0; cc < SCAN_D; ++cc) scan_issue(rsC, rsV, ring, cc, cc, p0, lane, dir, vlane);
    asm volatile("s_waitcnt vmcnt(18)" ::: "memory");
    SCAN_BAR();
    int slot = SCAN_D % SCAN_R;
    for (int c = 0; c < 512; ++c) {
        const int cn = c + SCAN_D < 512 ? c + SCAN_D : 511;
        scan_issue(rsC, rsV, ring, slot, cn, p0, lane, dir, vlane);
        slot = slot + 1 == SCAN_R ? 0 : slot + 1;
        asm volatile("s_waitcnt vmcnt(18)" ::: "memory");
        SCAN_BAR();
    }
    asm volatile("s_waitcnt vmcnt(0)" ::: "memory");
}
__device__ __forceinline__ void scan_block(Frame& F, int l) {
    const int scan = F.bid, b = scan >> 3, h = (scan >> 1) & 3, dir = scan & 1, lane = F.lane, g = lane >> 4;
    LAS unsigned char* ring = F.lds;
    if (F.wave >= 4) {
        const __amdgpu_buffer_rsrc_t rsC = G8_RSRC(F.ws + WS_CH + (size_t)scan * 512 * CHSZ);
        const __amdgpu_buffer_rsrc_t rsV = G8_RSRC(RWBUF(3) + (size_t)b * SEQ * 256);
        if (SCAN_VAR == 2 && F.dup) { SCAN_BAR(); for (int c = 0; c < 512; ++c) SCAN_BAR(); return; }
        scan_loader(rsC, rsV, ring, (F.wave - 4) * 3, lane, dir, (unsigned)(h * 128 + (lane & 7) * 16));
        return;
    }
    const int vcol = F.wave * 16 + (lane & 15), q4 = (lane & 15) >> 2, p4 = lane & 3;
    bf16_t* Yrow = (bf16_t*)(F.ws + WS_Y + (size_t)dir * RWB) + (size_t)b * SEQ * 256 + h * 64 + F.wave * 16 + (lane & 1) * 8;
    constexpr int YT_PITCH = 48;
    LAS unsigned char* ytile = F.lds + 112 * 1024 + F.wave * (16 * YT_PITCH);
    f32x4 S[4];
#pragma unroll
    for (int t = 0; t < 4; ++t) S[t] = (f32x4){0.f, 0.f, 0.f, 0.f};
    SCAN_BAR();
    struct Ops { bf16x8 AT0, AT1, R0, R1; s16x4 MT, MBR, MKR, Vb, Bt[4], Kt[4]; f32x4 gam[4]; };
    const int vtr = (4 * g + q4) * 128 + (16 * F.wave + 4 * p4) * 2;
#define SCAN_LOAD(o, ch) do { (o).AT0 = *(const LAS bf16x8*)((ch) + CH_AT + lane * 16); (o).AT1 = *(const LAS bf16x8*)((ch) + CH_AT + 1024 + lane * 16); \
        (o).R0 = *(const LAS bf16x8*)((ch) + CH_R + lane * 16); (o).R1 = *(const LAS bf16x8*)((ch) + CH_R + 1024 + lane * 16); \
        (o).MT = *(const LAS s16x4*)((ch) + CH_F8OFF(0, lane)); (o).MBR = *(const LAS s16x4*)((ch) + CH_F8OFF(1, lane)); (o).MKR = *(const LAS s16x4*)((ch) + CH_F8OFF(2, lane)); \
        (o).Vb = __builtin_amdgcn_ds_read_tr16_b64_v4i16((LAS s16x4*)((ch) + CHSZ + vtr)); \
        _Pragma("unroll") for (int t_ = 0; t_ < 4; ++t_) { (o).Bt[t_] = *(const LAS s16x4*)((ch) + CH_F8OFF(3 + t_, lane)); (o).Kt[t_] = *(const LAS s16x4*)((ch) + CH_F8OFF(7 + t_, lane)); \
            (o).gam[t_] = *(const LAS f32x4*)((ch) + CH_GAM + (16 * t_ + 4 * g) * 4); } } while (0)
#define SCAN_STEP(CUR, NXT, c) do { \
        u32x4 yprev = *(const LAS u32x4*)(ytile + ((lane >> 1) & 15) * YT_PITCH + (lane & 1) * 16);          \
        { const LAS unsigned char* chn = ring + slot * SLOTB; SCAN_LOAD(NXT, chn); } \
        slot = slot + 1 == SCAN_R ? 0 : slot + 1; \
        const bf16x8 Sb0 = pack44(S[0], S[1]), Sb1 = pack44(S[2], S[3]); \
        const f32x4 z4 = (f32x4){0.f, 0.f, 0.f, 0.f}; \
        f32x4 y = z4; \
        if (!(SCAN_VAR == 3 && F.dup)) { \
            f32x4 u = __builtin_amdgcn_mfma_f32_16x16x32_bf16((CUR).AT0, Sb0, z4, 0, 0, 0); \
            u = __builtin_amdgcn_mfma_f32_16x16x32_bf16((CUR).AT1, Sb1, u, 0, 0, 0); \
            u = mfma16pad((CUR).MT, (CUR).Vb, u, 0, 0, 0); \
            const s16x4 Ub = pack4(u); \
            asm volatile("" : "+v"(yprev));                     \
            y = __builtin_amdgcn_mfma_f32_16x16x32_bf16((CUR).R0, Sb0, z4, 0, 0, 0); \
            y = __builtin_amdgcn_mfma_f32_16x16x32_bf16((CUR).R1, Sb1, y, 0, 0, 0); \
            y = mfma16x2((CUR).MKR, (CUR).Vb, (CUR).MBR, Ub, y); \
            _Pragma("unroll") for (int t = 0; t < 4; ++t) { S[t] = S[t] * (CUR).gam[t]; S[t] = mfma16x2((CUR).Kt[t], (CUR).Vb, (CUR).Bt[t], Ub, S[t]); } \
        } \
        if ((c) && !(SCAN_VAR >= 1 && F.dup) && lane < 32) { const int tau = 16 * ((c) - 1) + (lane >> 1), t = dir ? SEQ - 1 - tau : tau; *(u32x4*)(Yrow + (size_t)t * 256) = yprev; } \
        if (!(SCAN_VAR >= 1 && F.dup)) {                        \
            _Pragma("unroll") for (int jj = 0; jj < 4; ++jj) *(LAS bf16_t*)(ytile + (4 * g + jj) * YT_PITCH + (lane & 15) * 2) = f2bf(y[jj]); } \
        asm volatile("s_waitcnt lgkmcnt(0)" ::: "memory");        \
        SCAN_BAR(); } while (0)
    Ops opA, opB; SCAN_LOAD(opA, ring);
    int slot = 1;
    for (int c = 0; c < 512; c += 2) { SCAN_STEP(opA, opB, c); SCAN_STEP(opB, opA, c + 1); }
#undef SCAN_STEP
    if (!(SCAN_VAR >= 1 && F.dup) && lane < 32) { const int tau = 16 * 511 + (lane >> 1), t = dir ? SEQ - 1 - tau : tau; *(u32x4*)(Yrow + (size_t)t * 256) = *(const LAS u32x4*)(ytile + (lane >> 1) * YT_PITCH + (lane & 1) * 16); }
#undef SCAN_LOAD
}
constexpr int WP_UNITS = 768;
__device__ __forceinline__ void phase_scanmix(Frame& F, int l) {
    if (F.bid < 64 && !(SCAN_VAR == 4 && F.dup)) scan_block(F, l);
    unsigned* ctr = (unsigned*)(F.ws + WS_CTL + 512 * KiB) + l * 64 + ((SCAN_VAR == 4 && F.dup) ? 32 : 0);
    volatile LAS int* qs = (volatile LAS int*)(F.lds + LDS_MISC + 64);
    const int n_kv = l == 0 ? 16 : 0, n_na = NB * 8 * NA_UPH, n_mem = NB * 4 * 8, total = n_kv + n_na + n_mem + (l == 0 ? WPA_UNITS : 0);
    unsigned* kvdone = (unsigned*)(F.ws + WS_CTL + 512 * KiB) + 192;
    bool kv_ok = (l != 0);
    for (;;) {
        refresh(F);
        __syncthreads();
        if (F.tid == 0) *qs = (int)__hip_atomic_fetch_add(ctr, 1u, __ATOMIC_RELAXED, __HIP_MEMORY_SCOPE_AGENT);
        __syncthreads();
        const int uq = __builtin_amdgcn_readfirstlane(*qs);
        if (uq >= total) break;
        if (uq < n_kv) {
            memkv_gemm(F, 0, uq);
            __syncthreads();
            if (F.tid == 0) { __builtin_amdgcn_fence(__ATOMIC_RELEASE, "agent"); asm volatile("s_waitcnt vmcnt(0)" ::: "memory"); (void)__hip_atomic_fetch_add(kvdone, 1u, __ATOMIC_RELAXED, __HIP_MEMORY_SCOPE_AGENT); }
            continue;
        }
        const int u = uq - n_kv;
        if (u < n_na) na_unit(F, l, u);
        else if (u < n_na + n_mem) {
            if (!kv_ok) {
                if (F.tid == 0) { unsigned sp = 0; while (__hip_atomic_load(kvdone, __ATOMIC_RELAXED, __HIP_MEMORY_SCOPE_AGENT) < 16u && ++sp < (1u << 22)) __builtin_amdgcn_s_sleep(2);
                    __builtin_amdgcn_fence(__ATOMIC_ACQUIRE, "agent"); asm volatile("s_waitcnt vmcnt(0)" ::: "memory"); }
                __syncthreads();
                kv_ok = true;
            }
            mem_unit(F, l, u - n_na);
        }
        else weight_prep(F, 1, F.bid - (u - n_na - n_mem), WPA_UNITS, 1);
    }
}

#endif
__device__ __forceinline__ void phase_rwpost(Frame& F, int l) {
    const bf16_t* Yf = (const bf16_t*)(F.ws + WS_Y); const bf16_t* Yb = (const bf16_t*)(F.ws + WS_Y + RWB);
    const bf16_t* Gb = RWBUF(8); const bf16_t* Bn = RWBUF(9);
    bf16_t* MIX = (bf16_t*)F.out;
    const float* lnw = F.in[17] + l * 256; const float* lnb = F.in[18] + l * 256;
    const int pair = F.lane >> 3, sub = F.lane & 7, h = pair & 3, c = h * 64 + sub * 8;
    float lw[8], lb[8];
#pragma unroll
    for (int e = 0; e < 8; ++e) { lw[e] = lnw[c + e]; lb[e] = lnb[c + e]; }
    u32x4 r0, r1, r2, r3;
    { const size_t idx = (size_t)((F.bid * NWAVES + F.wave) * 2 + (pair >> 2)) * 256 + c; r0 = *(const u32x4*)(Yf + idx); r1 = *(const u32x4*)(Yb + idx); r2 = *(const u32x4*)(Gb + idx); r3 = *(const u32x4*)(Bn + idx); }
    for (int wu = F.bid * NWAVES + F.wave; wu < NT / 2; wu += GRID * NWAVES) {
        const int tok = wu * 2 + (pair >> 2);
        float yf[8], yb[8], gg[8], bn[8];
        unpack8(r0, yf); unpack8(r1, yb); unpack8(r2, gg); unpack8(r3, bn);
        { const int wn = wu + GRID * NWAVES < NT / 2 ? wu + GRID * NWAVES : wu; const size_t idx = (size_t)(wn * 2 + (pair >> 2)) * 256 + c;
          r0 = *(const u32x4*)(Yf + idx); r1 = *(const u32x4*)(Yb + idx); r2 = *(const u32x4*)(Gb + idx); r3 = *(const u32x4*)(Bn + idx); }
        float s = 0.f;
#pragma unroll
        for (int e = 0; e < 8; ++e) { yf[e] += yb[e]; s += yf[e]; }
        s += __shfl_xor(s, 1); s += __shfl_xor(s, 2); s += __shfl_xor(s, 4);
        const float mu = s * (1.0f / 64.0f); float q = 0.f;
#pragma unroll
        for (int e = 0; e < 8; ++e) { yf[e] -= mu; q += yf[e] * yf[e]; }
        q += __shfl_xor(q, 1); q += __shfl_xor(q, 2); q += __shfl_xor(q, 4);
        const float rs = rsqrtf(q * (1.0f / 64.0f) + 64e-5f);
#pragma unroll
        for (int e = 0; e < 8; ++e) yf[e] = (yf[e] * rs * lw[e] + lb[e] + bn[e]) * gg[e];
        *(bf16x8*)(MIX + (size_t)tok * DM + 512 + c) = pack8(yf);
    }
}

struct ProbOutproj {
    g8::StaticOrder S; int wave; const bf16_t* A; const bf16_t* Bt; const bf16_t* xres; bf16_t* xb2; float* ssq;
    __device__ __forceinline__ bool next(int i, g8::Unit& u) const { return S.next(i, u); }
    __device__ __forceinline__ void setup(const g8::Unit& u, g8::GemmIn& gi) const { int R0, R1, C; g8::stage_coords_now(wave, R0, R1, C); g8::set_A_rows(gi, A, u.pm * 256, DM, R0, R1, C); g8::set_B(gi, Bt, Bt, u.pn * 256, u.pn * 256, 16, DM, R0, R1, C); }
    __device__ __forceinline__ g8::EpiResid epi(const g8::Unit& u) const { return g8::EpiResid{xres, nullptr, xb2, nullptr, ssq, u.pm * 256, u.pn * 256}; }
};
__device__ __forceinline__ void phase_outproj(Frame& F, int l) {
    bf16_t* WB = WSP(bf16_t, WS_W + (size_t)l * W_STRIDE);
    ProbOutproj pb; pb.wave = F.wave; pb.S.init(NT / 256, DM / 256, GRID, F.bid);
    pb.A = (const bf16_t*)F.out; pb.Bt = WB + W_OUT / 2; pb.xres = (const bf16_t*)((const char*)F.out + DO_XB); pb.xb2 = WSP(bf16_t, WS_XB2); pb.ssq = WSP(float, WS_SSQ2);
    g8::gemm_units<false>(F.lds, F.wave, F.lane, pb);
}

__device__ __forceinline__ void phase_router(Frame& F, int l) {
    LAS unsigned char* WRB = F.lds;
    LAS float* BIAS = (LAS float*)(F.lds + 131072);
    LAS int* HI = (LAS int*)(F.lds + 131072 + 128);
    LAS float* LG = (LAS float*)(F.lds + 131072 + 256) + F.wave * (16 * 33);
    const int lane = F.lane;
    { const u32x4* src = (const u32x4*)(F.ws + WS_WR2 + (size_t)l * WR_STRIDE);
#pragma unroll
        for (int i = 0; i < 16; ++i) *(LAS u32x4*)(WRB + (i * NTHREADS + F.tid) * 16) = src[i * NTHREADS + F.tid];
        if (F.tid < 8) *(LAS u32x4*)(WRB + 131072 + F.tid * 16) = src[8192 + F.tid]; }
    int* cls = WSP(int, WS_CLS); float* wlo = WSP(float, WS_WLO); float* whi = WSP(float, WS_WHI); float* rstd2 = WSP(float, WS_RSTD2); int* hist = WSP(int, WS_HIST);
    const bf16_t* X = WSP(bf16_t, WS_XB2); const float* ssq = WSP(float, WS_SSQ2);
    for (int tt = F.bid; tt < NT / 256; tt += GRID) {
        if (F.tid < 32) HI[F.tid] = 0;
        __syncthreads();
        for (int i = 0; i < 2; ++i) {
            const int tok0 = tt * 256 + (F.wave * 2 + i) * 16;
            const bf16_t* xp = X + (size_t)(tok0 + (lane & 15)) * DM + 8 * (lane >> 4);
            bf16x8 a[32];
#pragma unroll
            for (int ks = 0; ks < 32; ++ks) a[ks] = *(const bf16x8*)(xp + ks * 32);
            f32x4 c0 = {0.f, 0.f, 0.f, 0.f}, c1 = {0.f, 0.f, 0.f, 0.f}, e0 = {0.f, 0.f, 0.f, 0.f}, e1 = {0.f, 0.f, 0.f, 0.f};
#pragma unroll
            for (int ks = 0; ks < 32; ++ks) {
                const bf16x8 b0 = *(const LAS bf16x8*)(WRB + (ks * 64 + lane) * 16), b1 = *(const LAS bf16x8*)(WRB + ((32 + ks) * 64 + lane) * 16);
                const bf16x8 d0 = *(const LAS bf16x8*)(WRB + 65536 + (ks * 64 + lane) * 16), d1 = *(const LAS bf16x8*)(WRB + 65536 + ((32 + ks) * 64 + lane) * 16);
                c0 = __builtin_amdgcn_mfma_f32_16x16x32_bf16(a[ks], b0, c0, 0, 0, 0); c1 = __builtin_amdgcn_mfma_f32_16x16x32_bf16(a[ks], b1, c1, 0, 0, 0);
                e0 = __builtin_amdgcn_mfma_f32_16x16x32_bf16(a[ks], d0, e0, 0, 0, 0); e1 = __builtin_amdgcn_mfma_f32_16x16x32_bf16(a[ks], d1, e1, 0, 0, 0); }
            c0 += e0; c1 += e1;
#pragma unroll
            for (int r = 0; r < 4; ++r) { LG[(4 * (lane >> 4) + r) * 33 + (lane & 15)] = c0[r]; LG[(4 * (lane >> 4) + r) * 33 + 16 + (lane & 15)] = c1[r]; }
            const int tok = tok0 + (lane & 15);
            const float ss = (ssq[tok] + ssq[(size_t)NT + tok]) + (ssq[(size_t)2 * NT + tok] + ssq[(size_t)3 * NT + tok]);
            const float rs = rsqrtf(ss * (1.0f / DM) + 1e-6f);
            float lg[20];
#pragma unroll
            for (int o = 0; o < 20; ++o) lg[o] = LG[(lane & 15) * 33 + o] * rs + BIAS[o];
            int g = 0; float gm = lg[0];
#pragma unroll
            for (int o = 1; o < 4; ++o) if (lg[o] > gm) { gm = lg[o]; g = o; }
            float gs = 0.f;
#pragma unroll
            for (int o = 0; o < 4; ++o) gs += __expf(lg[o] - gm);
            const float gw = __builtin_amdgcn_rcpf(gs);
            float sel[4];
#pragma unroll
            for (int o = 0; o < 4; ++o) sel[o] = g == 0 ? lg[4 + o] : (g == 1 ? lg[8 + o] : (g == 2 ? lg[12 + o] : lg[16 + o]));
            int i1 = 0; float m1 = sel[0];
#pragma unroll
            for (int o = 1; o < 4; ++o) if (sel[o] > m1) { m1 = sel[o]; i1 = o; }
            int i2 = -1; float m2 = -3.0e38f;
#pragma unroll
            for (int o = 0; o < 4; ++o) if (o != i1 && sel[o] > m2) { m2 = sel[o]; i2 = o; }
            const float p1 = __builtin_amdgcn_rcpf(1.0f + __expf(m2 - m1)), p2 = 1.0f - p1;
            const int lo = i1 < i2 ? i1 : i2, hi = i1 < i2 ? i2 : i1;
            const float wl_ = gw * (i1 < i2 ? p1 : p2), wh_ = gw * (i1 < i2 ? p2 : p1);
            const int pair = lo == 0 ? hi - 1 : (lo == 1 ? hi + 1 : 5);
            const int c = g * 6 + pair;
            if (lane < 16) { cls[tok] = c; wlo[tok] = wl_; whi[tok] = wh_; rstd2[tok] = rs; atomicAdd((int*)&HI[c], 1); }
        }
        __syncthreads();
        if (F.tid < 32) hist[tt * 32 + F.tid] = HI[F.tid];
        __syncthreads();
    }
}

__device__ __forceinline__ void phase_scatter(Frame& F, int l) {
    LAS int* TOT = (LAS int*)F.lds;
    LAS int* BEF = TOT + 32;
    LAS int* RST = TOT + 64;
    LAS int* CL = TOT + 128;
    const int* cls = WSP(int, WS_CLS); const int* hist = WSP(int, WS_HIST);
    int* tokpos = WSP(int, WS_TOKPOS); float* wlos = WSP(float, WS_WLOS); float* whis = WSP(float, WS_WHIS); float* rstds = WSP(float, WS_RSTDS); int* tilecls = WSP(int, WS_TILECLS);
    for (int tt = F.bid; tt < NT / 256; tt += GRID) {
        {
            LAS int* PT = TOT + 512; LAS int* PB = TOT + 1024;
            const int c_ = F.tid & 31, sg = F.tid >> 5; int tot = 0, bef = 0;
#pragma unroll
            for (int k = 0; k < 16; ++k) { const int t2 = sg * 16 + k; const int hv = hist[t2 * 32 + c_]; tot += hv; bef += (t2 < tt) ? hv : 0; }
            PT[sg * 32 + c_] = tot; PB[sg * 32 + c_] = bef;
            __syncthreads();
            if (F.tid < 24) { int t = 0, b = 0;
#pragma unroll
                for (int s = 0; s < 16; ++s) { t += PT[s * 32 + F.tid]; b += PB[s * 32 + F.tid]; }
                TOT[F.tid] = t; BEF[F.tid] = b; } }
        if (F.tid < 256) CL[F.tid] = cls[tt * 256 + F.tid];
        __syncthreads();
        if (F.tid == 0) { int acc = 0; for (int c = 0; c < 24; ++c) { RST[c] = acc; acc += ((TOT[c] + 255) >> 8) << 8; } RST[24] = acc; }
        __syncthreads();
        if (F.tid < 256) {
            const int tok = tt * 256 + F.tid, c = CL[F.tid]; int rank = 0;
            for (int j = 0; j < F.tid; ++j) rank += (CL[j] == c) ? 1 : 0;
            const int pos = RST[c] + BEF[c] + rank;
            tokpos[pos] = tok; wlos[pos] = WSP(float, WS_WLO)[tok]; whis[pos] = WSP(float, WS_WHI)[tok]; rstds[pos] = WSP(float, WS_RSTD2)[tok];
        }
        if (tt == 0) {
            for (int c = 0; c < 24; ++c) {
                const int pend = RST[c + 1], p0 = RST[c] + TOT[c];
                for (int p = p0 + F.tid; p < pend; p += NTHREADS) { tokpos[p] = -1; wlos[p] = 0.f; whis[p] = 0.f; rstds[p] = 0.f; }
                for (int t = (RST[c] >> 8) + F.tid; t < (pend >> 8); t += NTHREADS) tilecls[t] = c;
            }
            if (F.tid == 0) tilecls[448] = RST[24] >> 8;
        }
        __syncthreads();
    }
}

__device__ __forceinline__ void cls_experts(int c, int& elo, int& ehi) {
    const int g = c / 6, p = c - g * 6;
    const int lo = p < 3 ? 0 : (p < 5 ? 1 : 2), hi = p < 3 ? p + 1 : (p < 5 ? p - 1 : 3);
    elo = g * 4 + lo; ehi = g * 4 + hi;
}
struct ProbMoeUp {
    g8::StaticOrder S; int wave; const int* tilecls; const int* tokpos; const bf16_t* A; const bf16_t* Bt; bf16_t* H; const float* rstds; const float* wlos; const float* whis;
    __device__ __forceinline__ bool next(int i, g8::Unit& u) const { return S.next(i, u); }
    __device__ __forceinline__ void setup(const g8::Unit& u, g8::GemmIn& gi) const { int R0, R1, C; g8::stage_coords_now(wave, R0, R1, C);
        int elo, ehi; cls_experts(__builtin_amdgcn_readfirstlane(tilecls[u.pm]), elo, ehi);
        const int e = u.pn < 4 ? elo : ehi;
        gi.rA = G8_RSRC(A); gi.sA = 0u; gi.hstepA = 0u; gi.va[0] = 0u; gi.va[1] = 0u;
#pragma unroll
        for (int h = 0; h < 2; ++h) { int t0 = tokpos[u.pm * 256 + h * 128 + R0], t1 = tokpos[u.pm * 256 + h * 128 + R1]; t0 = t0 < 0 ? 0 : t0; t1 = t1 < 0 ? 0 : t1;
            gi.vg[h][0] = (unsigned)(t0 * DM + C) * 2u; gi.vg[h][1] = (unsigned)(t1 * DM + C) * 2u; }
        const unsigned br = (unsigned)e * 1024u + (u.pn & 3) * 256u; g8::set_B(gi, Bt, Bt, br, br, 16, DM, R0, R1, C);
    }
    __device__ __forceinline__ g8::EpiGateUp epi(const g8::Unit& u) const { return g8::EpiGateUp{H, rstds, u.pn < 4 ? wlos : whis, u.pm * 256, u.pn * 128}; }
};
template <bool NEXTPREP> struct ProbMoeDown {
    g8::StaticOrder S; int wave; const int* tilecls; const int* tokpos; const bf16_t* A; const bf16_t* Bt; const bf16_t* xres; float* out; bf16_t* xb; float* ssq;
    __device__ __forceinline__ bool next(int i, g8::Unit& u) const { return S.next(i, u); }
    __device__ __forceinline__ void setup(const g8::Unit& u, g8::GemmIn& gi) const { int R0, R1, C; g8::stage_coords_now(wave, R0, R1, C);
        int elo, ehi; cls_experts(__builtin_amdgcn_readfirstlane(tilecls[u.pm]), elo, ehi);
        g8::set_A_rows(gi, A, u.pm * 256, DM, R0, R1, C);
        g8::set_B(gi, Bt, Bt, (unsigned)elo * 1024u + u.pn * 256u, (unsigned)ehi * 1024u + u.pn * 256u, 8, 512, R0, R1, C);
    }
    __device__ __forceinline__ g8::EpiResidT<true, !NEXTPREP> epi(const g8::Unit& u) const { return g8::EpiResidT<true, !NEXTPREP>{xres, out, xb, tokpos, NEXTPREP ? ssq : nullptr, u.pm * 256, u.pn * 256}; }
};
__device__ __forceinline__ void phase_moe_up(Frame& F, int l) {
    bf16_t* WB = WSP(bf16_t, WS_W + (size_t)l * W_STRIDE);
    ProbMoeUp pb; pb.wave = F.wave;
    pb.tilecls = WSP(int, WS_TILECLS); pb.tokpos = WSP(int, WS_TOKPOS);
    pb.S.init(__builtin_amdgcn_readfirstlane(pb.tilecls[448]), 8, GRID, F.bid);
    pb.A = WSP(bf16_t, WS_XB2); pb.Bt = WB + W_GU / 2; pb.H = WSP(bf16_t, WS_H); pb.rstds = WSP(float, WS_RSTDS); pb.wlos = WSP(float, WS_WLOS); pb.whis = WSP(float, WS_WHIS);
    g8::gemm_units<true>(F.lds, F.wave, F.lane, pb);
    if (l == 0) {
        const int total = __builtin_amdgcn_readfirstlane(pb.tilecls[448]) * 8, nmax = (total + GRID - 1) / GRID, nmine = F.bid < total ? (total - F.bid + GRID - 1) / GRID : 0;
        if (nmine < nmax) wp_tail(F, 3);
    }
}
template <bool NEXTPREP> __device__ __forceinline__ void moe_down_t(Frame& F, int l) {
    bf16_t* WB = WSP(bf16_t, WS_W + (size_t)l * W_STRIDE);
    ProbMoeDown<NEXTPREP> pb; pb.wave = F.wave;
    pb.tilecls = WSP(int, WS_TILECLS); pb.tokpos = WSP(int, WS_TOKPOS);
    pb.S.init(__builtin_amdgcn_readfirstlane(pb.tilecls[448]), 4, GRID, F.bid);
    pb.A = WSP(bf16_t, WS_H); pb.Bt = WB + W_DN / 2; pb.xres = WSP(bf16_t, WS_XB2); pb.out = F.out; pb.xb = (bf16_t*)((char*)F.out + DO_XB); pb.ssq = WSP(float, WS_SSQ);
    g8::gemm_units<false>(F.lds, F.wave, F.lane, pb);
}
__device__ __forceinline__ void phase_moe_down(Frame& F, int l) {
    if (l == 0) { moe_down_t<true>(F, l); refresh(F); memkv_gemm(F, 1, GRID - 1 - F.bid); wp_tail(F, 1 << 20); }
    else moe_down_t<false>(F, l);
}

#if SELFTEST
#define ST_NCHK 40
#define ST_ACC(F) ((float*)((F).ws + WS_CTL + 512 * KiB))
__device__ __forceinline__ void st_add(float* acc, int chk, float mine, float ref) { const float d = mine - ref; atomicAdd(&acc[chk * 2], d * d); atomicAdd(&acc[chk * 2 + 1], ref * ref); }

__device__ void st_rwprep(Frame& F, int tok, int l) {
    const bf16_t* P = WSP(bf16_t, WS_P); float* acc = ST_ACC(F);
    const float* mup = F.in[7] + l * 1152; const float* mun = F.in[8] + l * 1152; const float* w0 = F.in[9] + l * 512; const float* w2 = F.in[10] + (size_t)l * 2 * 64 * 256; const float* a0 = F.in[11] + l * 512; const float* a2 = F.in[12] + (size_t)l * 2 * 64 * 256; const float* g2 = F.in[13] + (size_t)l * 128 * 256;
    const float* k_k = F.in[14] + l * 256; const float* k_a = F.in[15] + l * 256; const float* r_k = F.in[16] + l * 256;
    LAS float* SH = (LAS float*)F.lds;
    LAS float* RD = SH + 1152;
    const int t = tok & (SEQ - 1);
    for (int c = F.tid; c < 1152; c += NTHREADS) {
        const float s = bf2f(P[(size_t)tok * PIN + C_RW + c]);
        const float pv = t == 0 ? 0.f : bf2f(P[(size_t)(tok - 1) * PIN + C_RW + c]);
        const float nx = t == SEQ - 1 ? 0.f : bf2f(P[(size_t)(tok + 1) * PIN + C_RW + c]);
        SH[c] = s + mup[c] * (pv - s) + mun[c] * (nx - s);
    }
    __syncthreads();
    const int c = F.tid & 255;
    float wf = w0[c], wb = w0[256 + c], af = a0[c], ab = a0[256 + c], g = 0.f;
    for (int j = 0; j < 64; ++j) { wf += tanhf(SH[768 + j]) * w2[j * 256 + c]; wb += tanhf(SH[832 + j]) * w2[(64 + j) * 256 + c]; af += SH[896 + j] * a2[j * 256 + c]; ab += SH[960 + j] * a2[(64 + j) * 256 + c]; }
    for (int j = 0; j < 128; ++j) g += (1.0f / (1.0f + expf(-SH[1024 + j]))) * g2[j * 256 + c];
    const float r = SH[c], k = SH[256 + c], v = SH[512 + c];
    const float ef = expf(-log1pf(expf(-wf)) - 0.5f), eb = expf(-log1pf(expf(-wb)) - 0.5f);
    af = 1.0f / (1.0f + expf(-af)); ab = 1.0f / (1.0f + expf(-ab));
    const float kx = k * k_k[c]; const float kdf = k * (1.0f + (af - 1.0f) * k_a[c]), kdb = k * (1.0f + (ab - 1.0f) * k_a[c]);
    if (F.tid < 256) { RD[c] = kx * kx; RD[256 + c] = r * (kdf + kdb) * r_k[c]; }
    __syncthreads();
    float ss = 0.f, bs = 0.f; for (int j = 0; j < 64; ++j) { ss += RD[(c & ~63) + j]; bs += RD[256 + (c & ~63) + j]; }
    const float kk = kx / fmaxf(sqrtf(ss), 1e-12f);
    if (F.tid < 256) {
        const size_t o = (size_t)tok * 256 + c;
        const float ref[10] = {r, k, kk, v, ef, eb, af, ab, g, bs * v};
#pragma unroll
        for (int q = 0; q < 10; ++q) st_add(acc, 0 + q, bf2f(RWBUF(q)[o]), ref[q]);
    }
    __syncthreads();
}
__device__ void st_scan(Frame& F, int b, int h, int dir, int l) {
    if (F.wave != 0) return;
    constexpr int NST = 40; float* acc = ST_ACC(F);
    const int lane = F.lane; const float* k_a = F.in[15] + l * 256;
    float S[64];
#pragma unroll
    for (int k = 0; k < 64; ++k) S[k] = 0.f;
    const bf16_t* Y = (const bf16_t*)(F.ws + WS_Y + (size_t)dir * RWB);
    for (int step = 0; step < NST; ++step) {
        const int t = dir ? SEQ - 1 - step : step; const size_t rowo = ((size_t)b * SEQ + t) * 256 + h * 64;
        const float v = bf2f(RWBUF(3)[rowo + lane]);
        float sa = 0.f;
#pragma unroll
        for (int k = 0; k < 64; ++k) sa -= S[k] * bf2f(RWBUF(2)[rowo + k]);
        float y = 0.f;
#pragma unroll
        for (int k = 0; k < 64; ++k) {
            const float kk = bf2f(RWBUF(2)[rowo + k]), a = bf2f(RWBUF(6 + dir)[rowo + k]), e = bf2f(RWBUF(4 + dir)[rowo + k]), kr = bf2f(RWBUF(1)[rowo + k]), r = bf2f(RWBUF(0)[rowo + k]);
            S[k] = S[k] * expf(-e) + sa * (kk * a) + v * (kr * (1.0f + (a - 1.0f) * k_a[h * 64 + k])); y += S[k] * r; }
        st_add(acc, 10 + dir, bf2f(Y[rowo + lane]), y);
    }
}
__device__ void st_rwpost(Frame& F, int tok, int l) {
    float* acc = ST_ACC(F); LAS float* RD = (LAS float*)F.lds;
    const bf16_t* Yf = (const bf16_t*)(F.ws + WS_Y); const bf16_t* Yb = (const bf16_t*)(F.ws + WS_Y + RWB); const bf16_t* MIX = WSP(bf16_t, WS_XB);
    const int c = F.tid & 255; const size_t o = (size_t)tok * 256 + c;
    const float y = bf2f(Yf[o]) + bf2f(Yb[o]);
    if (F.tid < 256) RD[c] = y;
    __syncthreads();
    float mu = 0.f; for (int j = 0; j < 64; ++j) mu += RD[(c & ~63) + j]; mu *= (1.0f / 64.0f);
    float var = 0.f; for (int j = 0; j < 64; ++j) { const float d = RD[(c & ~63) + j] - mu; var += d * d; } var *= (1.0f / 64.0f);
    const float yn = (y - mu) / sqrtf(var + 64e-5f) * F.in[17][l * 256 + c] + F.in[18][l * 256 + c];
    if (F.tid < 256) st_add(acc, 12, bf2f(MIX[(size_t)tok * DM + 512 + c]), (yn + bf2f(RWBUF(9)[o])) * bf2f(RWBUF(8)[o]));
    __syncthreads();
}
__device__ void st_moe(Frame& F, int tok, int l) {
    float* acc = ST_ACC(F);
    LAS float* X = (LAS float*)F.lds;
    LAS float* HID = X + 1024;
    LAS float* RD = HID + 1024;
    LAS float* LG = RD + 512;
    const bf16_t* xb2 = WSP(bf16_t, WS_XB2); const float* nw = F.in[24] + l * DM;
    float ss = 0.f;
    for (int i = F.tid; i < DM; i += NTHREADS) { const float v = bf2f(xb2[(size_t)tok * DM + i]); X[i] = v; ss += v * v; }
    RD[F.tid] = ss; __syncthreads();
    float tot = 0.f; for (int j = 0; j < NTHREADS; ++j) tot += RD[j];
    const float rs = 1.0f / sqrtf(tot / DM + 1e-6f);
    __syncthreads();
    for (int i = F.tid; i < DM; i += NTHREADS) X[i] = X[i] * rs * nw[i];
    __syncthreads();
    if (F.tid < 20) { float a = 0.f; const int o = F.tid; for (int k = 0; k < DM; ++k) a += X[k] * (o < 4 ? F.in[25][(size_t)l * DM * 4 + k * 4 + o] : F.in[27][(size_t)l * DM * 16 + k * 16 + o - 4]); LG[o] = a + (o < 4 ? F.in[26][l * 4 + o] : F.in[28][l * 16 + o - 4]); }
    __syncthreads();
    int g = 0; for (int o = 1; o < 4; ++o) if (LG[o] > LG[g]) g = o;
    float gs = 0.f; for (int o = 0; o < 4; ++o) gs += expf(LG[o] - LG[g]); const float gw = 1.0f / gs;
    int i1 = 0; for (int o = 1; o < 4; ++o) if (LG[4 + g * 4 + o] > LG[4 + g * 4 + i1]) i1 = o;
    int i2 = -1; for (int o = 0; o < 4; ++o) if (o != i1 && (i2 < 0 || LG[4 + g * 4 + o] > LG[4 + g * 4 + i2])) i2 = o;
    const float p1 = 1.0f / (1.0f + expf(LG[4 + g * 4 + i2] - LG[4 + g * 4 + i1])), p2 = 1.0f - p1;
    const int ee[2] = {g * 4 + i1, g * 4 + i2}; const float ww[2] = {gw * p1, gw * p2};
    for (int s = 0; s < 2; ++s) {
        const float* wg = F.in[29] + ((size_t)l * 16 + ee[s]) * DM * 512; const float* wu = F.in[30] + ((size_t)l * 16 + ee[s]) * DM * 512;
        const int j = F.tid;
        float ga = 0.f, ua = 0.f; for (int k = 0; k < DM; ++k) { ga += X[k] * wg[(size_t)k * 512 + j]; ua += X[k] * wu[(size_t)k * 512 + j]; }
        HID[s * 512 + j] = ga / (1.0f + expf(-ga)) * ua * ww[s];
    }
    __syncthreads();
    for (int n = F.tid; n < DM; n += NTHREADS) {
        float y = 0.f;
        for (int s = 0; s < 2; ++s) { const float* wd = F.in[31] + ((size_t)l * 16 + ee[s]) * 512 * DM; for (int j = 0; j < 512; ++j) y += HID[s * 512 + j] * wd[(size_t)j * DM + n]; }
        st_add(acc, 14, F.out[(size_t)tok * DM + n] - bf2f(xb2[(size_t)tok * DM + n]), y);
    }
    if (F.tid == 0) { const int lo = i1 < i2 ? i1 : i2, hi = i1 < i2 ? i2 : i1; const int pair = lo == 0 ? hi - 1 : (lo == 1 ? hi + 1 : 5);
        const int mine = WSP(int, WS_CLS)[tok]; atomicAdd(&acc[13 * 2], mine == g * 6 + pair ? 0.f : 1.f); atomicAdd(&acc[13 * 2 + 1], 1.f); }
    __syncthreads();
}

__device__ void st_g1(Frame& F, int tok, int l) {
    float* acc = ST_ACC(F); LAS float* X = (LAS float*)F.lds; LAS float* RD = X + 1024;
    const float* xs = (l == 0 ? F.in[0] : F.out) + (size_t)tok * DM; const float* nw = F.in[2] + l * DM; const float* w = F.in[3] + (size_t)l * DM * PIN;
    float ss = 0.f; for (int i = F.tid; i < DM; i += NTHREADS) { const float v = xs[i]; X[i] = v * nw[i]; ss += v * v; }
    RD[F.tid] = ss; __syncthreads();
    float tot = 0.f; for (int j = 0; j < NTHREADS; ++j) tot += RD[j];
    const float rs = 1.0f / sqrtf(tot / DM + 1e-6f);
    for (int col = F.tid; col < PIN; col += NTHREADS) { float a = 0.f; for (int k = 0; k < DM; ++k) a += X[k] * w[(size_t)k * PIN + col]; st_add(acc, 15, bf2f(WSP(bf16_t, WS_P)[(size_t)tok * PIN + col]), a * rs); }
    __syncthreads();
}
__device__ void st_memkv(Frame& F, int row, int l) {
    float* acc = ST_ACC(F); LAS float* X = (LAS float*)F.lds; LAS float* RD = X + 1024;
    const float* xs = F.in[1] + (size_t)row * DM; const float* nw = F.in[19] + l * DM; const float* w = F.in[20] + (size_t)l * DM * 512;
    float ss = 0.f; for (int i = F.tid; i < DM; i += NTHREADS) { const float v = xs[i]; X[i] = v * nw[i]; ss += v * v; }
    RD[F.tid] = ss; __syncthreads();
    float tot = 0.f; for (int j = 0; j < NTHREADS; ++j) tot += RD[j];
    const float rs = 1.0f / sqrtf(tot / DM + 1e-6f);
    { const int col = F.tid; float a = 0.f; for (int k = 0; k < DM; ++k) a += X[k] * w[(size_t)k * 512 + col]; st_add(acc, 16, bf2f(WSP(bf16_t, WS_MEMKV)[(size_t)row * 512 + col]), a * rs); }
    __syncthreads();
}
__device__ void st_na(Frame& F, int tok, int l) {
    float* acc = ST_ACC(F); const bf16_t* P = WSP(bf16_t, WS_P);
    const int h = F.tid >> 6, d = F.tid & 63; const int b = tok >> 13, sidx = tok & (SEQ - 1), r = sidx >> 6, c = sidx & 63;
    const float* wq = F.in[4] + l * 64; const float* wk = F.in[5] + l * 64; const float* rpb = F.in[6] + (size_t)l * 8 * 15 * 31;
    float q[64]; float ss = 0.f;
#pragma unroll
    for (int i = 0; i < 64; ++i) { q[i] = bf2f(P[(size_t)tok * PIN + h * 64 + i]); ss += q[i] * q[i]; }
    { const float rs = 1.0f / sqrtf(ss / 64.0f + 1e-6f);
#pragma unroll
      for (int i = 0; i < 64; ++i) q[i] = q[i] * rs * wq[i]; }
    const int rs0 = min(max(r - 4, 0), 120), cs0 = min(max(c - 8, 0), 48);
    float mx = -1e30f;
    for (int pass = 0; pass < 2; ++pass) {
        float den = 0.f, o = 0.f;
        for (int n = 0; n < 8; ++n) for (int m = 0; m < 16; ++m) {
            const size_t kt = (size_t)b * SEQ + (rs0 + n) * 64 + cs0 + m; const bf16_t* kp = P + kt * PIN + C_K + h * 64;
            float ks = 0.f, dt = 0.f;
#pragma unroll
            for (int i = 0; i < 64; ++i) { const float kv = bf2f(kp[i]); ks += kv * kv; dt += q[i] * kv * wk[i]; }
            const float s = dt / sqrtf(ks / 64.0f + 1e-6f) * 0.125f + rpb[((size_t)h * 15 + (rs0 + n - r + 7)) * 31 + (cs0 + m - c + 15)];
            if (pass == 0) mx = fmaxf(mx, s); else { const float p = expf(s - mx); den += p; o += p * bf2f(P[kt * PIN + C_V + h * 64 + d]); }
        }
        if (pass == 1) st_add(acc, 17, bf2f(WSP(bf16_t, WS_XB)[(size_t)tok * DM + h * 64 + d]), o / den);
    }
}
__device__ void st_mem(Frame& F, int tok, int l) {
    if (F.tid >= 256) return;
    float* acc = ST_ACC(F); const bf16_t* P = WSP(bf16_t, WS_P); const bf16_t* MKV = WSP(bf16_t, WS_MEMKV);
    const int h = F.tid >> 6, d = F.tid & 63; const int b = tok >> 13;
    const float* wq = F.in[21] + l * 64; const float* wk = F.in[22] + l * 64;
    float q[64]; float ss = 0.f;
#pragma unroll
    for (int i = 0; i < 64; ++i) { q[i] = bf2f(P[(size_t)tok * PIN + C_MQ + h * 64 + i]); ss += q[i] * q[i]; }
    { const float rs = 1.0f / sqrtf(ss / 64.0f + 1e-6f);
#pragma unroll
      for (int i = 0; i < 64; ++i) q[i] = q[i] * rs * wq[i]; }
    float mx = -1e30f;
    for (int pass = 0; pass < 2; ++pass) {
        float den = 0.f, o = 0.f;
        for (int m = 0; m < NMEM; ++m) {
            const bf16_t* kp = MKV + ((size_t)b * NMEM + m) * 512 + h * 64;
            float ks = 0.f, dt = 0.f;
#pragma unroll
            for (int i = 0; i < 64; ++i) { const float kv = bf2f(kp[i]); ks += kv * kv; dt += q[i] * kv * wk[i]; }
            const float s = dt / sqrtf(ks / 64.0f + 1e-6f) * 0.125f;
            if (pass == 0) mx = fmaxf(mx, s); else { const float p = expf(s - mx); den += p; o += p * bf2f(kp[256 + d]); }
        }
        if (pass == 1) st_add(acc, 18, bf2f(WSP(bf16_t, WS_XB)[(size_t)tok * DM + 768 + h * 64 + d]), o / den);
    }
}
__device__ void st_g3(Frame& F, int tok) {
    float* acc = ST_ACC(F); const bf16_t* MIX = WSP(bf16_t, WS_XB); const float* w = F.in[23];
    for (int col = F.tid; col < DM; col += NTHREADS) { float a = 0.f; for (int k = 0; k < DM; ++k) a += bf2f(MIX[(size_t)tok * DM + k]) * w[(size_t)k * DM + col];
        st_add(acc, 19, bf2f(WSP(bf16_t, WS_XB2)[(size_t)tok * DM + col]), F.in[0][(size_t)tok * DM + col] + a); }
}
__device__ void st_scan_full(Frame& F, int b, int h, int dir, int l) {
    if (F.wave != 0) return;
    float* acc = ST_ACC(F); const int lane = F.lane; const float* k_a = F.in[15] + l * 256;
    float S[64];
#pragma unroll
    for (int k = 0; k < 64; ++k) S[k] = 0.f;
    const bf16_t* Y = (const bf16_t*)(F.ws + WS_Y + (size_t)dir * RWB);
    float num = 0.f, den = 0.f;
    for (int step = 0; step < SEQ; ++step) {
        const int t = dir ? SEQ - 1 - step : step; const size_t rowo = ((size_t)b * SEQ + t) * 256 + h * 64;
        const float v = bf2f(RWBUF(3)[rowo + lane]);
        float sa = 0.f;
#pragma unroll
        for (int k = 0; k < 64; ++k) sa -= S[k] * bf2f(RWBUF(2)[rowo + k]);
        float y = 0.f;
#pragma unroll
        for (int k = 0; k < 64; ++k) {
            const float kk = bf2f(RWBUF(2)[rowo + k]), a = bf2f(RWBUF(6 + dir)[rowo + k]), e = bf2f(RWBUF(4 + dir)[rowo + k]), kr = bf2f(RWBUF(1)[rowo + k]), r = bf2f(RWBUF(0)[rowo + k]);
            S[k] = S[k] * expf(-e) + sa * (kk * a) + v * (kr * (1.0f + (a - 1.0f) * k_a[h * 64 + k])); y += S[k] * r; }
        const float dd = bf2f(Y[rowo + lane]) - y; num += dd * dd; den += y * y;
    }
    atomicAdd(&acc[(20 + dir) * 2], num); atomicAdd(&acc[(20 + dir) * 2 + 1], den);
}
__global__ void __launch_bounds__(NTHREADS, 2) selftest_k(Args args, int part, int l) {
    extern __shared__ __attribute__((aligned(16))) unsigned char lds_raw[];
    Frame F; F.lds = (LAS unsigned char*)lds_raw; F.bid = blockIdx.x; F.wave = __builtin_amdgcn_readfirstlane((int)(threadIdx.x >> 6)); refresh(F);
    const int bid = F.bid;
    const int tok = (int)(((unsigned)bid * 2654435761u) >> 16) & (NT - 1);
    if (part == 0) {
        if (bid < 96) st_rwprep(F, bid < 4 ? (bid & 1 ? SEQ - 1 : 0) + (bid >> 1) * SEQ * 3 : tok, l);
        else if (bid < 100) st_scan(F, (bid - 96) * 2 + 1, bid & 3, 0, l);
        else if (bid < 104) st_scan(F, (bid - 100) * 2, (bid + 1) & 3, 1, l);
        else if (bid < 168) st_rwpost(F, tok, l);
        else if (bid < 200) st_g1(F, tok, l);
        else if (bid < 216) st_memkv(F, tok & (NMROWS - 1), l);
        else if (bid < 280) st_na(F, bid < 224 ? ((bid & 1) ? 63 : 0) + ((bid >> 1) & 3) * SEQ * 2 + ((bid >> 1) & 1 ? (SEQ - 64) : 0) : tok, l);
        else if (bid < 312) st_mem(F, tok, l);
        else if (bid < 316) st_scan_full(F, (bid * 3) & 7, bid & 3, bid & 1, l);
    } else { if (bid < 64) st_moe(F, tok, l); else if (bid < 96 && l == 0) st_g3(F, tok); }
}
__global__ void selftest_encode(Args args, int first, int last, float thr) {
    const float* acc = (const float*)((unsigned char*)args.tab[33] + WS_CTL + 512 * KiB);
    float s = 1.0f;
    for (int c = last; c >= first; --c) { const float num = acc[c * 2], den = acc[c * 2 + 1]; const bool bad = (c == 13) ? (num > 0.08f * den) : !(num <= thr * thr * den); if (bad || den == 0.f) s = -(float)(1 + c - first); }
#if defined(ST_MAG)
    { const float num = acc[ST_MAG * 2], den = acc[ST_MAG * 2 + 1]; float dl = sqrtf(num / fmaxf(den, 1e-30f)); dl = fminf(dl, 0.6f); s = -(1.0f + rintf(dl * 100.0f)); if (!(den > 0.f)) s = -80.f; }
#endif
    const float* x = args.tab[0]; float* out = (float*)args.tab[32];
    for (size_t i = (size_t)blockIdx.x * blockDim.x + threadIdx.x; i < (size_t)NT * DM; i += (size_t)gridDim.x * blockDim.x) out[i] = x[i] * s;
}
#endif

__global__ void __launch_bounds__(NTHREADS, 2) fwd(Args args) {
    extern __shared__ __attribute__((aligned(16))) unsigned char lds_raw[];
    Frame F;
    F.lds = (LAS unsigned char*)lds_raw; F.bid = blockIdx.x; F.wave = __builtin_amdgcn_readfirstlane((int)(threadIdx.x >> 6));
    refresh(F); F.dup = 0;
    volatile LAS unsigned* xbw = (volatile LAS unsigned*)(F.lds + LDS_MISC);
    if (F.tid < 4) xbw[F.tid] = 0u;
    __syncthreads();
    const int lo = args.ph_lo, hi = args.ph_hi;
    const bool multi = (hi - lo) > 1;
    XcdBarrier bar; bar.bar = (unsigned*)(F.ws + WS_CTL); bar.x = 0; bar.st = xbw;
    if (multi) bar = xcd_barrier_post((unsigned*)(F.ws + WS_CTL), xbw, F.tid == 0);
#ifndef ONLY_PH
#define ONLY_PH -1
#endif
#define IN(k) (lo <= (k) && (k) < hi)
#define EN(k) (ONLY_PH < 0 || ONLY_PH == (k))
#define SEAM(k) do { if (IN(k) && IN((k) + 1)) { refresh(F); xcd_barrier(bar, F.tid == 0); } } while (0)
#if EXTRA_BARS
    for (int eb = 0; eb < EXTRA_BARS; ++eb) { refresh(F); xcd_barrier(bar, F.tid == 0); }
#endif
#define PHASE(k, call) do { if (EN(k) && IN(pb + (k))) { refresh(F); call; if (DUP_PH == (k) && l == 0) { refresh(F); xcd_barrier(bar, F.tid == 0); refresh(F); F.dup = 1; call; F.dup = 0; } } SEAM(pb + (k)); } while (0)
    for (int l = 0; l < 2; ++l) {
        const int pb = l * NPH;
        if (l == 0) { if (EN(0) && IN(pb + 0)) { refresh(F); phase_prep(F, l); }
        SEAM(pb + 0); }
        PHASE(1, phase_inproj(F, l));
        PHASE(2, phase_rwprep(F, l));
        PHASE(3, phase_scanmix(F, l));
        PHASE(4, phase_rwpost(F, l));
        PHASE(5, phase_outproj(F, l));
        PHASE(6, phase_router(F, l));
        PHASE(7, phase_scatter(F, l));
        PHASE(8, phase_moe_up(F, l));
        PHASE(9, phase_moe_down(F, l));
    }
#undef PHASE
#undef IN
#undef SEAM
}

extern "C" void kernel_launch(void* const* d_in, const int* in_sizes, int n_in, void* d_out, int out_size, void* d_ws, size_t ws_size, hipStream_t stream) {
    static int grid = 0;
    if (grid == 0) {
        if (n_in != 32 || in_sizes[0] != NT * DM || out_size != NT * DM || ws_size < WS_END) {
            fprintf(stderr, "kernel_launch: unexpected shapes: n_in %d in0 %d out %d ws %zu (need %zu)\n", n_in, n_in > 0 ? in_sizes[0] : -1, out_size, ws_size, (size_t)WS_END); grid = -1; return; }
        int dev = 0, cus = 0, per_cu = 0;
        if (hipGetDevice(&dev) != hipSuccess || hipDeviceGetAttribute(&cus, hipDeviceAttributeMultiprocessorCount, dev) != hipSuccess) { grid = -1; return; }
        if (hipFuncSetAttribute((const void*)fwd, hipFuncAttributeMaxDynamicSharedMemorySize, LDS_BYTES) != hipSuccess) { fprintf(stderr, "kernel_launch: hipFuncSetAttribute failed\n"); grid = -1; return; }
        if (hipOccupancyMaxActiveBlocksPerMultiprocessor(&per_cu, (const void*)fwd, NTHREADS, LDS_BYTES) != hipSuccess || per_cu < 1)
            fprintf(stderr, "kernel_launch: occupancy query says %d blocks per CU\n", per_cu);
        (void)hipGetLastError();
        if (cus < GRID) { fprintf(stderr, "kernel_launch: built for %d CUs, device has %d\n", GRID, cus); grid = -1; return; }
        grid = GRID;
    }
    if (grid < 0) return;
    (void)hipMemsetAsync((char*)d_ws + WS_CTL, 0, 1 * MiB, stream);
    Args a{};
    for (int i = 0; i < 32; ++i) a.tab[i] = (const float*)d_in[i];
    a.tab[32] = (const float*)d_out; a.tab[33] = (const float*)d_ws;
#if MK_ONE_LAUNCH
    a.ph_lo = 0; a.ph_hi = 2 * NPH;
    hipLaunchKernelGGL(fwd, dim3(grid), dim3(NTHREADS), LDS_BYTES, stream, a);
#else
#if SELFTEST
    { static bool once = false; if (!once) { once = true; (void)hipFuncSetAttribute((const void*)selftest_k, hipFuncAttributeMaxDynamicSharedMemorySize, LDS_BYTES); } }
    for (int p = 0; p < NPH; ++p) { a.ph_lo = p; a.ph_hi = p + 1; hipLaunchKernelGGL(fwd, dim3(grid), dim3(NTHREADS), LDS_BYTES, stream, a);
        if (p == 6) hipLaunchKernelGGL(selftest_k, dim3(316), dim3(NTHREADS), LDS_BYTES, stream, a, 0, 0); }
    hipLaunchKernelGGL(selftest_k, dim3(96), dim3(NTHREADS), LDS_BYTES, stream, a, 1, 0);
    hipLaunchKernelGGL(selftest_encode, dim3(2048), dim3(256), 0, stream, a, ST_FIRST, ST_LAST, 0.05f);
    return;
#endif
    for (int p = 0; p < 2 * NPH; ++p) { a.ph_lo = p; a.ph_hi = p + 1; hipLaunchKernelGGL(fwd, dim3(grid), dim3(NTHREADS), LDS_BYTES, stream, a); }
#endif
}
```
